# Optimizing an MI355X kernel written in HIP

```python
import math
import jax, jax.numpy as jnp
from jax import lax
import numpy as np

D_MODEL = 1024
BATCH = 32
SEQ = 256
DEPTH = 4
DEC_BATCH = 2
DEC_SEQ = 1024
PAST_LEN = 512

GRID_W = 64
N_MIXERS = 2
N_NA_LAYERS = (DEPTH + 1) // 2
N_SSM_LAYERS = DEPTH // 2
NA_HEADS = 16
HEAD_DIM = D_MODEL // NA_HEADS
ATTN_SCALE = HEAD_DIM ** -0.5
WIN_R = 8
WIN_C = 16
Q_BLOCK_C = 16
KEY_BLOCK_C = 2 * WIN_C
ATTN_Q_BLOCK = 128
SSM_GROUP = 16
SSM_GROUPS = D_MODEL // SSM_GROUP
SSM_STATE = 64
N_DIR = 2
D_FF = -(-8 * D_MODEL // (3 * 256)) * 256
N_MOD = 6
EPS = 1e-6

kernel_name = "hybrid_natten_s5_diffusion_step"


def rms_norm(x, g):
    xf = x.astype(jnp.float32)
    y = xf * lax.rsqrt(jnp.mean(xf * xf, axis=-1, keepdims=True) + EPS)
    return (y * g.astype(jnp.float32)).astype(x.dtype)


def ada_modulation(cond, w, b):
    m = jax.nn.silu(cond) @ w + b
    return jnp.split(m[..., None, :], N_MOD, axis=-1)


def modulate(h, shift, scale):
    return h * (1.0 + scale) + shift


def swiglu(h, w1, w3, w2):
    return (jax.nn.silu(h @ w1) * (h @ w3)) @ w2


def na_qkv(h, w_qkv, q_gain, k_gain):
    b, n, _ = h.shape
    qkv = (h @ w_qkv).reshape(b, n, 3, NA_HEADS, HEAD_DIM)
    q = rms_norm(qkv[:, :, 0], q_gain)
    k = rms_norm(qkv[:, :, 1], k_gain)
    return q, k, qkv[:, :, 2]


def context_attention(q, k, v):
    b, s, h, d = q.shape
    nblk = s // ATTN_Q_BLOCK
    qb = jnp.moveaxis(q.reshape(b, nblk, ATTN_Q_BLOCK, h, d), 1, 0)

    def one_block(qi):
        sc = jnp.einsum('bqhd,bshd->bhqs', qi, k).astype(jnp.float32) * ATTN_SCALE
        p = jax.nn.softmax(sc, axis=-1).astype(v.dtype)
        return jnp.einsum('bhqs,bshd->bqhd', p, v)

    o = lax.map(one_block, qb)
    return jnp.moveaxis(o, 0, 1).reshape(b, s, h * d)


def neighbourhood_attention(q, k, v, k_ctx, v_ctx, rpb):
    b, n, h, d = q.shape
    rows = n // GRID_W
    kr = min(WIN_R, rows)
    ncb = GRID_W // Q_BLOCK_C
    r = jnp.arange(rows)
    row_start = jnp.clip(r - kr // 2, 0, rows - kr)
    key_rows = row_start[:, None] + jnp.arange(kr)
    cb = jnp.arange(ncb) * Q_BLOCK_C
    key_col0 = jnp.clip(cb - WIN_C // 2, 0, GRID_W - KEY_BLOCK_C)
    key_cols = key_col0[:, None] + jnp.arange(KEY_BLOCK_C)
    q_cols = cb[:, None] + jnp.arange(Q_BLOCK_C)
    col_start = jnp.clip(q_cols - WIN_C // 2, 0, GRID_W - WIN_C)
    rel = key_cols[:, None, :] - col_start[:, :, None]
    in_win = (rel >= 0) & (rel < WIN_C)
    dc = jnp.clip(key_cols[:, None, :] - q_cols[:, :, None], -(WIN_C - 1), WIN_C - 1)
    dr = key_rows - r[:, None]
    bias = rpb[:, dr[:, None, None, :, None] + (WIN_R - 1), dc[None, :, :, None, :] + (WIN_C - 1)]
    bias = jnp.where(in_win[None, None, :, :, None, :], bias.astype(jnp.float32), -jnp.inf)
    k_grid = k.reshape(b, rows, GRID_W, h, d)
    v_grid = v.reshape(b, rows, GRID_W, h, d)
    ridx = key_rows[:, :, None, None]
    cidx = key_cols[None, None, :, :]
    kg = k_grid[:, ridx, cidx]
    vg = v_grid[:, ridx, cidx]
    qg = q.reshape(b, rows, ncb, Q_BLOCK_C, h, d)
    s_loc = jnp.einsum('brnqhd,brknchd->bhrnqkc', qg, kg).astype(jnp.float32) * ATTN_SCALE + bias[None]
    s_ctx = jnp.einsum('brnqhd,bshd->bhrnqs', qg, k_ctx).astype(jnp.float32) * ATTN_SCALE
    n_loc = kr * KEY_BLOCK_C
    scores = jnp.concatenate([s_loc.reshape(s_loc.shape[:5] + (n_loc,)), s_ctx], axis=-1)
    p = jax.nn.softmax(scores, axis=-1).astype(v.dtype)
    p_loc = p[..., :n_loc].reshape(s_loc.shape)
    p_ctx = p[..., n_loc:]
    o = jnp.einsum('bhrnqkc,brknchd->brnqhd', p_loc, vg) + jnp.einsum('bhrnqs,bshd->brnqhd', p_ctx, v_ctx)
    return o.reshape(b, n, h * d)


def s5_discretise(lam_re, lam_im, log_step, b_re, b_im):
    f32 = jnp.float32
    lam_re, lam_im = lam_re.astype(f32), lam_im.astype(f32)
    step = jnp.exp(log_step.astype(f32))[:, None]
    mag = jnp.exp(lam_re * step)
    a_re, a_im = mag * jnp.cos(lam_im * step), mag * jnp.sin(lam_im * step)
    den = lam_re * lam_re + lam_im * lam_im
    nr, ni = a_re - 1.0, a_im
    f_re = (nr * lam_re + ni * lam_im) / den
    f_im = (ni * lam_re - nr * lam_im) / den
    b_re, b_im = b_re.astype(f32), b_im.astype(f32)
    bb_re = f_re[..., None] * b_re - f_im[..., None] * b_im
    bb_im = f_re[..., None] * b_im + f_im[..., None] * b_re
    return a_re, a_im, bb_re, bb_im


def s5_scan(a_re, a_im, bu_re, bu_im, reverse):
    A_re = jnp.broadcast_to(a_re, bu_re.shape)
    A_im = jnp.broadcast_to(a_im, bu_re.shape)

    def combine(e1, e2):
        a1r, a1i, b1r, b1i = e1
        a2r, a2i, b2r, b2i = e2
        return (a2r * a1r - a2i * a1i, a2r * a1i + a2i * a1r,
                a2r * b1r - a2i * b1i + b2r, a2r * b1i + a2i * b1r + b2i)

    _, _, x_re, x_im = lax.associative_scan(combine, (A_re, A_im, bu_re, bu_im), axis=1, reverse=reverse)
    return x_re, x_im


def s5_mixer(u, lam_re, lam_im, log_step, b_re, b_im, c_re, c_im, d_skip, w_glu, h0_re, h0_im, return_state):
    f32 = jnp.float32
    bsz, length, _ = u.shape
    uf = u.astype(f32)
    ug = uf.reshape(bsz, length, SSM_GROUPS, SSM_GROUP)
    y = ug * d_skip.astype(f32).reshape(SSM_GROUPS, SSM_GROUP)
    fin_re, fin_im = [], []
    for dr in range(N_DIR):
        reverse = dr == 1
        a_re, a_im, bb_re, bb_im = s5_discretise(lam_re[dr], lam_im[dr], log_step[dr], b_re[dr], b_im[dr])
        bu_re = jnp.einsum('gpc,blgc->blgp', bb_re, ug)
        bu_im = jnp.einsum('gpc,blgc->blgp', bb_im, ug)
        if h0_re is not None:
            pos = length - 1 if reverse else 0
            s_re = h0_re[:, dr].astype(f32)
            s_im = h0_im[:, dr].astype(f32)
            bu_re = bu_re.at[:, pos].add(a_re * s_re - a_im * s_im)
            bu_im = bu_im.at[:, pos].add(a_re * s_im + a_im * s_re)
        x_re, x_im = s5_scan(a_re, a_im, bu_re, bu_im, reverse)
        y = y + jnp.einsum('gcp,blgp->blgc', c_re[dr].astype(f32), x_re) \
              - jnp.einsum('gcp,blgp->blgc', c_im[dr].astype(f32), x_im)
        if return_state:
            end = 0 if reverse else length - 1
            fin_re.append(x_re[:, end])
            fin_im.append(x_im[:, end])
    z = jax.nn.gelu(y.reshape(bsz, length, D_MODEL)).astype(u.dtype)
    val, gate = jnp.split(z @ w_glu, 2, axis=-1)
    out = val * jax.nn.sigmoid(gate)
    if return_state:
        return out, jnp.stack(fin_re, axis=1).astype(u.dtype), jnp.stack(fin_im, axis=1).astype(u.dtype)
    return out


def setup_inputs(seed: int = 0) -> dict:
    key = jax.random.key(seed)
    ks = jax.random.split(key, 32)
    f32 = jnp.float32

    def nrm(i, shape, s):
        return jax.random.normal(ks[i], shape, f32) * s

    d = D_MODEL
    lam_im_base = jnp.pi * jnp.arange(SSM_STATE, dtype=f32)
    return {
        "x_prompt": nrm(0, (BATCH, SEQ, d), 1.0),
        "x_sample": nrm(1, (DEC_BATCH, DEC_SEQ, d), 1.0),
        "cache_k": nrm(2, (DEC_BATCH, N_NA_LAYERS, PAST_LEN, NA_HEADS, HEAD_DIM), 1.0),
        "cache_v": nrm(3, (DEC_BATCH, N_NA_LAYERS, PAST_LEN, NA_HEADS, HEAD_DIM), 1.0),
        "state_ssm_re": nrm(4, (DEC_BATCH, N_SSM_LAYERS, N_DIR, SSM_GROUPS, SSM_STATE), 0.3),
        "state_ssm_im": nrm(5, (DEC_BATCH, N_SSM_LAYERS, N_DIR, SSM_GROUPS, SSM_STATE), 0.3),
        "c": nrm(6, (DEC_BATCH, d), 1.0),
        "c_ctx": nrm(7, (d,), 1.0),
        "norm_mix": 1.0 + nrm(8, (DEPTH, d), 0.02),
        "norm_ffn": 1.0 + nrm(9, (DEPTH, d), 0.02),
        "ada_w": nrm(10, (DEPTH, d, N_MOD * d), 0.5 * d ** -0.5),
        "ada_b": nrm(11, (DEPTH, N_MOD * d), 0.02),
        "na_w_qkv": nrm(12, (N_NA_LAYERS, d, 3 * d), d ** -0.5),
        "na_w_o": nrm(13, (N_NA_LAYERS, d, d), d ** -0.5),
        "na_q_gain": 1.0 + nrm(14, (N_NA_LAYERS, HEAD_DIM), 0.02),
        "na_k_gain": 1.0 + nrm(15, (N_NA_LAYERS, HEAD_DIM), 0.02),
        "na_rpb": nrm(16, (N_NA_LAYERS, NA_HEADS, 2 * WIN_R - 1, 2 * WIN_C - 1), 0.02),
        "ssm_lambda_re": -0.5 + nrm(17, (N_SSM_LAYERS, N_DIR, SSM_GROUPS, SSM_STATE), 0.01),
        "ssm_lambda_im": lam_im_base + nrm(18, (N_SSM_LAYERS, N_DIR, SSM_GROUPS, SSM_STATE), 0.01),
        "ssm_log_step": jax.random.uniform(ks[19], (N_SSM_LAYERS, N_DIR, SSM_GROUPS), f32,
                                           minval=math.log(1e-3), maxval=math.log(1e-1)),
        "ssm_b_re": nrm(20, (N_SSM_LAYERS, N_DIR, SSM_GROUPS, SSM_STATE, SSM_GROUP), SSM_GROUP ** -0.5),
        "ssm_b_im": nrm(21, (N_SSM_LAYERS, N_DIR, SSM_GROUPS, SSM_STATE, SSM_GROUP), SSM_GROUP ** -0.5),
        "ssm_c_re": nrm(22, (N_SSM_LAYERS, N_DIR, SSM_GROUPS, SSM_GROUP, SSM_STATE), SSM_STATE ** -0.5),
        "ssm_c_im": nrm(23, (N_SSM_LAYERS, N_DIR, SSM_GROUPS, SSM_GROUP, SSM_STATE), SSM_STATE ** -0.5),
        "ssm_d": nrm(24, (N_SSM_LAYERS, d), 1.0),
        "ssm_w_glu": nrm(25, (N_SSM_LAYERS, d, 2 * d), d ** -0.5),
        "ffn_w1": nrm(26, (DEPTH, d, D_FF), d ** -0.5),
        "ffn_w3": nrm(27, (DEPTH, d, D_FF), d ** -0.5),
        "ffn_w2": nrm(28, (DEPTH, D_FF, d), D_FF ** -0.5),
    }


def reference(x_prompt, x_sample, cache_k, cache_v, state_ssm_re, state_ssm_im, c, c_ctx,
              norm_mix, norm_ffn, ada_w, ada_b,
              na_w_qkv, na_w_o, na_q_gain, na_k_gain, na_rpb,
              ssm_lambda_re, ssm_lambda_im, ssm_log_step, ssm_b_re, ssm_b_im, ssm_c_re, ssm_c_im,
              ssm_d, ssm_w_glu, ffn_w1, ffn_w3, ffn_w2):
    xp, xs = x_prompt, x_sample
    new_k, new_v, new_sre, new_sim = [], [], [], []
    for i in range(DEPTH):
        j = i // N_MIXERS
        m_ctx = ada_modulation(c_ctx, ada_w[i], ada_b[i])
        m_lat = ada_modulation(c, ada_w[i], ada_b[i])
        hp = modulate(rms_norm(xp, norm_mix[i]), m_ctx[0], m_ctx[1])
        hs = modulate(rms_norm(xs, norm_mix[i]), m_lat[0], m_lat[1])
        if i % N_MIXERS == 0:
            qp, kp, vp = na_qkv(hp, na_w_qkv[j], na_q_gain[j], na_k_gain[j])
            op = context_attention(qp, kp, vp) @ na_w_o[j]
            new_k.append(kp)
            new_v.append(vp)
            qs, ks_, vs = na_qkv(hs, na_w_qkv[j], na_q_gain[j], na_k_gain[j])
            os_ = neighbourhood_attention(qs, ks_, vs, cache_k[:, j], cache_v[:, j], na_rpb[j]) @ na_w_o[j]
        else:
            op, sre, sim = s5_mixer(hp, ssm_lambda_re[j], ssm_lambda_im[j], ssm_log_step[j],
                                    ssm_b_re[j], ssm_b_im[j], ssm_c_re[j], ssm_c_im[j],
                                    ssm_d[j], ssm_w_glu[j], None, None, True)
            new_sre.append(sre)
            new_sim.append(sim)
            os_ = s5_mixer(hs, ssm_lambda_re[j], ssm_lambda_im[j], ssm_log_step[j],
                           ssm_b_re[j], ssm_b_im[j], ssm_c_re[j], ssm_c_im[j],
                           ssm_d[j], ssm_w_glu[j], state_ssm_re[:, j], state_ssm_im[:, j], False)
        xp = xp + m_ctx[2] * op
        xs = xs + m_lat[2] * os_
        hp = modulate(rms_norm(xp, norm_ffn[i]), m_ctx[3], m_ctx[4])
        hs = modulate(rms_norm(xs, norm_ffn[i]), m_lat[3], m_lat[4])
        xp = xp + m_ctx[5] * swiglu(hp, ffn_w1[i], ffn_w3[i], ffn_w2[i])
        xs = xs + m_lat[5] * swiglu(hs, ffn_w1[i], ffn_w3[i], ffn_w2[i])
    new_cache_k = jnp.stack(new_k, axis=1)
    new_cache_v = jnp.stack(new_v, axis=1)
    new_state_ssm_re = jnp.stack(new_sre, axis=1)
    new_state_ssm_im = jnp.stack(new_sim, axis=1)
    return (xp, xs, new_cache_k, new_cache_v, new_state_ssm_re, new_state_ssm_im)
```

```cpp
#include <hip/hip_runtime.h>
#include <hip/hip_cooperative_groups.h>
#include <cstdio>
#include <cstdint>
namespace cg = cooperative_groups;

typedef unsigned short bf16_t;
typedef __attribute__((ext_vector_type(8))) short bf16x8;
typedef __attribute__((ext_vector_type(4))) short s16x4;
typedef __attribute__((ext_vector_type(4))) float f32x4;
typedef __attribute__((ext_vector_type(4))) unsigned u32x4;
typedef __attribute__((ext_vector_type(2))) unsigned u32x2;
#define LAS __attribute__((address_space(3)))

constexpr int DM = 1024;
constexpr int NCTX = 8192;
constexpr int NLAT = 2048;
constexpr int NTOK = 10240;
constexpr int DFF = 2816;
constexpr int NMOD = 6144;

constexpr size_t OUT_X   = 0;
constexpr size_t OUT_NK  = 10485760;
constexpr size_t OUT_NV  = 27262976;
constexpr size_t OUT_SRE = 44040192;
constexpr size_t OUT_SIM = 44564480;

constexpr size_t WS_WQKV = 0;
constexpr size_t WS_WO   = WS_WQKV + 12582912;
constexpr size_t WS_WGLU = WS_WO   + 4194304;
constexpr size_t WS_W13  = WS_WGLU + 8388608;
constexpr size_t WS_W2   = WS_W13  + 46137344;
constexpr size_t WS_MOD  = WS_W2   + 23068672;
constexpr size_t WS_CK   = WS_MOD  + 294912;
constexpr size_t WS_CV   = WS_CK   + 4194304;
constexpr size_t WS_H    = WS_CV   + 4194304;
constexpr size_t WS_R    = WS_H    + 20971520;
constexpr size_t WS_Q    = WS_R;
constexpr size_t WS_K    = WS_Q + 20971520;
constexpr size_t WS_V    = WS_K + 20971520;
constexpr size_t WS_O    = WS_V + 20971520;
constexpr size_t WS_U    = WS_R;
constexpr size_t WS_HF   = WS_R;
constexpr size_t WS_YF   = WS_HF + 41943040;
constexpr size_t WS_YB   = WS_YF + 41943040;
constexpr size_t WS_BAR  = WS_R + 125829120;
constexpr size_t WS_DISC = WS_BAR + 16384;
constexpr size_t WS_END  = WS_DISC + 262144;

constexpr int SMEM_STAGE = 131072;
constexpr int SMEM_BYTES = 147456 + 64;
constexpr int SMEM_BAR = 147456;
constexpr int HALF_LDS = 40960;

struct Params {
  const float *x_prompt, *x_sample, *cache_k, *cache_v, *st_re, *st_im, *c, *c_ctx;
  const float *norm_mix, *norm_ffn, *ada_w, *ada_b, *w_qkv, *w_o, *q_gain, *k_gain, *rpb;
  const float *lam_re, *lam_im, *log_step, *b_re, *b_im, *c_re, *c_im, *ssm_d, *w_glu, *w1, *w3, *w2;
  float* out;
  unsigned char* ws;
};

__device__ __forceinline__ unsigned f2bf(float f) {
  unsigned u = __float_as_uint(f);
  u += 0x7fffu + ((u >> 16) & 1u);
  return u >> 16;
}
typedef __bf16 bf16n2 __attribute__((ext_vector_type(2)));
typedef float f32x2 __attribute__((ext_vector_type(2)));
__device__ __forceinline__ unsigned pack2(float a, float b) { f32x2 v = {a, b}; bf16n2 r = __builtin_convertvector(v, bf16n2); return __builtin_bit_cast(unsigned, r); }
__device__ __forceinline__ float silu_f(float x) { return x * __builtin_amdgcn_rcpf(1.f + __expf(-x)); }
__device__ __forceinline__ float gelu_tanh(float y) {
  float a = 1.5957691216057308f * (y + 0.044715f * y * y * y);
  return y * __builtin_amdgcn_rcpf(1.f + __expf(-a));
}
__device__ __forceinline__ int tid_opaque() { int t = threadIdx.x; asm volatile("" : "+v"(t)); return t; }
__device__ __forceinline__ f32x4 zero4() { f32x4 z = {0.f, 0.f, 0.f, 0.f}; return z; }

__device__ __forceinline__ int map_row(int n, int mode, int off) {
  if (mode == 0) return n;
  if (mode == 1) return (n >> 4) * 32 + off + (n & 15);
  const int np = n & 255;
  return (n & ~255) + 128 * ((np >> 5) & 1) + 32 * (np >> 6) + (np & 31);
}
__device__ __forceinline__ void transpose_tile(bool valid, int tl, const float* __restrict__ src, int src_ld, int k0, int n0_src,
                                               bf16_t* __restrict__ dst, int dst_ld, int n0_map, int mode, int off,
                                               float* T) {
  const int c4 = (tl & 15) * 4, r = tl >> 4;
  if (valid) {
    f32x4 v[8];
#pragma unroll
    for (int i = 0; i < 4; i++) {
      const float* sp = src + (size_t)(k0 + r + 16 * i) * src_ld + n0_src + c4;
      v[i] = *(const f32x4*)sp; v[4 + i] = *(const f32x4*)(sp + 64);
    }
    asm volatile("" :: "v"(v[0]), "v"(v[1]), "v"(v[2]), "v"(v[3]), "v"(v[4]), "v"(v[5]), "v"(v[6]), "v"(v[7]));
#pragma unroll
    for (int i = 0; i < 4; i++) {
      const int rr = r + 16 * i;
      T[rr * 65 + c4 + 0] = v[i][0]; T[rr * 65 + c4 + 1] = v[i][1]; T[rr * 65 + c4 + 2] = v[i][2]; T[rr * 65 + c4 + 3] = v[i][3];
      T[4160 + rr * 65 + c4 + 0] = v[4 + i][0]; T[4160 + rr * 65 + c4 + 1] = v[4 + i][1]; T[4160 + rr * 65 + c4 + 2] = v[4 + i][2]; T[4160 + rr * 65 + c4 + 3] = v[4 + i][3];
    }
  }
  __syncthreads();
  if (valid) {
    const int nn = tl >> 2, k16 = (tl & 3) * 16;
#pragma unroll
    for (int h2 = 0; h2 < 2; h2++) {
      const float* Th = T + h2 * 4160;
      const int drow = map_row(n0_map + 64 * h2 + nn, mode, off);
      unsigned w0 = pack2(Th[(k16 + 0) * 65 + nn], Th[(k16 + 1) * 65 + nn]);
      unsigned w1 = pack2(Th[(k16 + 2) * 65 + nn], Th[(k16 + 3) * 65 + nn]);
      unsigned w2 = pack2(Th[(k16 + 4) * 65 + nn], Th[(k16 + 5) * 65 + nn]);
      unsigned w3 = pack2(Th[(k16 + 6) * 65 + nn], Th[(k16 + 7) * 65 + nn]);
      unsigned w4 = pack2(Th[(k16 + 8) * 65 + nn], Th[(k16 + 9) * 65 + nn]);
      unsigned w5 = pack2(Th[(k16 + 10) * 65 + nn], Th[(k16 + 11) * 65 + nn]);
      unsigned w6 = pack2(Th[(k16 + 12) * 65 + nn], Th[(k16 + 13) * 65 + nn]);
      unsigned w7 = pack2(Th[(k16 + 14) * 65 + nn], Th[(k16 + 15) * 65 + nn]);
      uint4* d = (uint4*)(dst + (size_t)drow * dst_ld + k0 + k16);
      d[0] = make_uint4(w0, w1, w2, w3);
      d[1] = make_uint4(w4, w5, w6, w7);
    }
  }
  __syncthreads();
}

__device__ __forceinline__ void ada_item(const Params& p, bool valid, int tl, int it, float* sm) {
  const int layer = it / 96, cb = it % 96;
  const int w = tl >> 6, lane = tl & 63;
  if (valid) {
    for (int i = tl; i < 3072; i += 256) {
      int cnd = i >> 10, k = i & 1023;
      float v = (cnd == 0) ? p.c_ctx[k] : p.c[(cnd - 1) * 1024 + k];
      sm[i] = v / (1.f + expf(-v));
    }
  }
  __syncthreads();
  float* red = sm + 3072;
  if (valid) {
    const float* wp = p.ada_w + (size_t)layer * 1024 * NMOD + (size_t)(w * 256) * NMOD + cb * 64 + lane;
    float a0 = 0.f, a1 = 0.f, a2 = 0.f;
    for (int k0 = 0; k0 < 256; k0 += 16) {
      float wv[16];
#pragma unroll
      for (int j = 0; j < 16; j++) wv[j] = wp[(size_t)(k0 + j) * NMOD];
      __builtin_amdgcn_sched_barrier(0);
#pragma unroll
      for (int j = 0; j < 16; j++) {
        const int kk = w * 256 + k0 + j;
        a0 += sm[kk] * wv[j]; a1 += sm[1024 + kk] * wv[j]; a2 += sm[2048 + kk] * wv[j];
      }
    }
    red[(w * 3 + 0) * 64 + lane] = a0;
    red[(w * 3 + 1) * 64 + lane] = a1;
    red[(w * 3 + 2) * 64 + lane] = a2;
  }
  __syncthreads();
  if (valid && tl < 192) {
    int cnd = tl >> 6, l = tl & 63;
    float s = red[(0 * 3 + cnd) * 64 + l] + red[(1 * 3 + cnd) * 64 + l] + red[(2 * 3 + cnd) * 64 + l] + red[(3 * 3 + cnd) * 64 + l];
    int n = cb * 64 + l;
    float* mod = (float*)(p.ws + WS_MOD);
    mod[(size_t)(layer * 3 + cnd) * NMOD + n] = s + p.ada_b[layer * NMOD + n];
  }
  __syncthreads();
}

__device__ __forceinline__ void sincos_d(double x, double& s, double& c) {
  const double n = rint(x * 0.15915494309189533576888);
  double r = fma(-n, 6.283185307179586, x);
  r = fma(-n, 2.4492935982947064e-16, r);
  const double r2 = r * r;
  double ss = 1.0, cc = 1.0;
#pragma unroll
  for (int k = 14; k >= 1; k--) {
    ss = 1.0 - ss * r2 * (1.0 / (double)((2 * k) * (2 * k + 1)));
    cc = 1.0 - cc * r2 * (1.0 / (double)((2 * k - 1) * (2 * k)));
  }
  s = r * ss; c = cc;
}


__device__ void prep_items(const Params& p, unsigned char* smem, int stage, int vb, int nvb, int part) {
  const int t = tid_opaque();
  const int hb = t >> 8, tl = t & 255;
  float* T = (float*)(smem + hb * HALF_LDS);
  const int jl = stage >> 1;
  const bool na = !(stage & 1);
  const int S_ADA = (stage == 0 && gridDim.x != 256) ? 384 : 0;
  const int S_MIX = S_ADA + (na ? 384 + 128 : 256);
  const int S_W1 = S_MIX + 352, S_W3 = S_W1 + 352, S_W2 = S_W3 + 352;
  const int S_CKV = S_W2 + (stage == 0 ? 2048 : 0);
  const int S_END = S_CKV + (stage == 0 ? 64 : 0);
  const int plo = (part == 1) ? (S_MIX >> 1) : 0;
  const int phi = (part == 1) ? (S_W2 >> 1) : (S_END >> 1);
  for (int pi = plo + vb; pi < phi; pi += nvb) {
    if (part == 0 && pi * 2 >= S_MIX && pi * 2 < S_W2) continue;
    const int it = pi * 2 + hb;
    const bool valid = it < S_END;
    if (pi * 2 < S_ADA) {
      ada_item(p, valid, tl, it, T);
    } else if (pi * 2 < S_MIX) {
      int r = it - S_ADA;
      if (na) {
        if (r < 384) {
          int kt = r / 24, nt = r % 24;
          transpose_tile(valid, tl, p.w_qkv + (size_t)jl * 1024 * 3072, 3072, kt * 64, nt * 128,
                         (bf16_t*)(p.ws + WS_WQKV) + (size_t)jl * 3072 * 1024, 1024, nt * 128, 2, 0, T);
        } else {
          r -= 384; int kt = r / 8, nt = r % 8;
          transpose_tile(valid, tl, p.w_o + (size_t)jl * 1024 * 1024, 1024, kt * 64, nt * 128,
                         (bf16_t*)(p.ws + WS_WO) + (size_t)jl * 1024 * 1024, 1024, nt * 128, 0, 0, T);
        }
      } else {
        int kt = r / 16, nt = r % 16;
        int n0 = nt * 128;
        int gate = n0 >= 1024;
        transpose_tile(valid, tl, p.w_glu + (size_t)jl * 1024 * 2048, 2048, kt * 64, n0,
                       (bf16_t*)(p.ws + WS_WGLU) + (size_t)jl * 2048 * 1024, 1024, gate ? n0 - 1024 : n0, 1, gate ? 16 : 0, T);
      }
    } else if (pi * 2 < S_W1) {
      int r = it - S_MIX; int kt = r / 22, nt = r % 22;
      transpose_tile(valid, tl, p.w1 + (size_t)stage * 1024 * DFF, DFF, kt * 64, nt * 128,
                     (bf16_t*)(p.ws + WS_W13) + (size_t)stage * 5632 * 1024, 1024, nt * 128, 1, 0, T);
    } else if (pi * 2 < S_W3) {
      int r = it - S_W1; int kt = r / 22, nt = r % 22;
      transpose_tile(valid, tl, p.w3 + (size_t)stage * 1024 * DFF, DFF, kt * 64, nt * 128,
                     (bf16_t*)(p.ws + WS_W13) + (size_t)stage * 5632 * 1024, 1024, nt * 128, 1, 16, T);
    } else if (pi * 2 < S_W2) {
      int r = it - S_W3; int kt = r / 8, nt = r % 8;
      transpose_tile(valid, tl, p.w2 + (size_t)stage * DFF * 1024, 1024, kt * 64, nt * 128,
                     (bf16_t*)(p.ws + WS_W2) + (size_t)stage * 1024 * DFF, DFF, nt * 128, 0, 0, T);
    } else if (pi * 2 < S_CKV) {
      int r = it - S_W2; const int isv = r >= 1024; r &= 1023;
      int bjh = r >> 4, sc = r & 15; int bj = bjh >> 4, h = bjh & 15;
      int s = sc * 32 + (tl >> 3), d8 = (tl & 7) * 8;
      const float* src = (isv ? p.cache_v : p.cache_k) + ((size_t)(bj * 512 + s) * 16 + h) * 64 + d8;
      float4 v0 = *(const float4*)src, v1 = *(const float4*)(src + 4);
      bf16_t* dst = (bf16_t*)(p.ws + (isv ? WS_CV : WS_CK)) + ((size_t)bjh * 512 + s) * 64 + d8;
      *(uint4*)dst = make_uint4(pack2(v0.x, v0.y), pack2(v0.z, v0.w), pack2(v1.x, v1.y), pack2(v1.z, v1.w));
    } else if (valid) {
      const int idx = (it - S_CKV) * 256 + tl;
      const double lr = (double)p.lam_re[idx], li = (double)p.lam_im[idx];
      const double step = exp((double)p.log_step[idx >> 6]);
      const double mag = exp(lr * step);
      double sn, cs;
      sincos_d(li * step, sn, cs);
      const double are = mag * cs, aim = mag * sn;
      const double den = lr * lr + li * li;
      const double nr = are - 1.0, ni = aim;
      float4 o;
      o.x = (float)are; o.y = (float)aim;
      o.z = (float)((nr * lr + ni * li) / den);
      o.w = (float)((ni * lr - nr * li) / den);
      ((float4*)(p.ws + WS_DISC))[idx] = o;
    }
  }
}

__device__ void ada_stage(const Params& p, unsigned char* smem, int layer, int vb, int nvb) {
  const int t = tid_opaque();
  const int w = t >> 6, lane = t & 63;
  float* sm = (float*)smem;
  float* red = sm + 3072;
  for (int cb = vb; cb < 96; cb += nvb) {
    for (int i = t; i < 3072; i += 512) {
      int cnd = i >> 10, k = i & 1023;
      float v = (cnd == 0) ? p.c_ctx[k] : p.c[(cnd - 1) * 1024 + k];
      sm[i] = v / (1.f + expf(-v));
    }
    __syncthreads();
    const float* wp = p.ada_w + (size_t)layer * 1024 * NMOD + (size_t)(w * 128) * NMOD + cb * 64 + lane;
    float a0 = 0.f, a1 = 0.f, a2 = 0.f;
    for (int k0 = 0; k0 < 128; k0 += 16) {
      float wv[16];
#pragma unroll
      for (int j = 0; j < 16; j++) wv[j] = wp[(size_t)(k0 + j) * NMOD];
      __builtin_amdgcn_sched_barrier(0);
#pragma unroll
      for (int j = 0; j < 16; j++) {
        const int kk = w * 128 + k0 + j;
        a0 += sm[kk] * wv[j]; a1 += sm[1024 + kk] * wv[j]; a2 += sm[2048 + kk] * wv[j];
      }
    }
    red[(w * 3 + 0) * 64 + lane] = a0;
    red[(w * 3 + 1) * 64 + lane] = a1;
    red[(w * 3 + 2) * 64 + lane] = a2;
    __syncthreads();
    if (t < 192) {
      const int cnd = t >> 6, l = t & 63;
      float s = 0.f;
#pragma unroll
      for (int ww = 0; ww < 8; ww++) s += red[(ww * 3 + cnd) * 64 + l];
      const int n = cb * 64 + l;
      float* mod = (float*)(p.ws + WS_MOD);
      mod[(size_t)(layer * 3 + cnd) * NMOD + n] = s + p.ada_b[layer * NMOD + n];
    }
    __syncthreads();
  }
}

__device__ void norm_phase(const float* __restrict__ xctx, const float* __restrict__ xlat,
                           const float* __restrict__ g, const float* __restrict__ modl, int chunk,
                           bf16_t* __restrict__ h, float* __restrict__ hf, float* __restrict__ xcopy) {
  const int t_ = tid_opaque(); const int lane = t_ & 63, w = t_ >> 6;
  const int rstep = gridDim.x * 8;
  int row = blockIdx.x * 8 + w;
  f32x4 nv0, nv1, nv2, nv3;
  {
    const float* xr = (row < NCTX) ? xctx + (size_t)row * DM : xlat + (size_t)(row - NCTX) * DM;
    nv0 = *(const f32x4*)(xr + lane * 4); nv1 = *(const f32x4*)(xr + lane * 4 + 256);
    nv2 = *(const f32x4*)(xr + lane * 4 + 512); nv3 = *(const f32x4*)(xr + lane * 4 + 768);
  }
  for (; row < NTOK; row += rstep) {
    f32x4 v[4] = {nv0, nv1, nv2, nv3};
    const int rn = row + rstep;
    if (rn < NTOK) {
      const float* xr = (rn < NCTX) ? xctx + (size_t)rn * DM : xlat + (size_t)(rn - NCTX) * DM;
      nv0 = *(const f32x4*)(xr + lane * 4); nv1 = *(const f32x4*)(xr + lane * 4 + 256);
      nv2 = *(const f32x4*)(xr + lane * 4 + 512); nv3 = *(const f32x4*)(xr + lane * 4 + 768);
    }
    float ss = 0.f;
#pragma unroll
    for (int i = 0; i < 4; i++) ss += v[i][0] * v[i][0] + v[i][1] * v[i][1] + v[i][2] * v[i][2] + v[i][3] * v[i][3];
#pragma unroll
    for (int o = 32; o >= 1; o >>= 1) ss += __shfl_xor(ss, o);
    const float rstd = 1.0f / sqrtf(ss * (1.f / 1024.f) + 1e-6f);
    const int cond = (row < NCTX) ? 0 : 1 + ((row - NCTX) >> 10);
    const float* sh = modl + (size_t)cond * NMOD + chunk * 1024;
    const float* sc = sh + 1024;
#pragma unroll
    for (int i = 0; i < 4; i++) {
      int col = lane * 4 + 256 * i;
      float4 gg = *(const float4*)(g + col);
      float4 s1 = *(const float4*)(sc + col);
      float4 s0 = *(const float4*)(sh + col);
      float y0 = v[i][0] * rstd * gg.x * (1.f + s1.x) + s0.x;
      float y1 = v[i][1] * rstd * gg.y * (1.f + s1.y) + s0.y;
      float y2 = v[i][2] * rstd * gg.z * (1.f + s1.z) + s0.z;
      float y3 = v[i][3] * rstd * gg.w * (1.f + s1.w) + s0.w;
      if (h) *(uint2*)(h + (size_t)row * DM + col) = make_uint2(pack2(y0, y1), pack2(y2, y3));
      if (hf) *(float4*)(hf + (size_t)row * DM + col) = make_float4(y0, y1, y2, y3);
      if (xcopy) *(f32x4*)(xcopy + (size_t)row * DM + col) = v[i];
    }
  }
}

namespace pg8 {
constexpr int BM = 256, BK = 64, HALF = 128, HTB = HALF * BK * 2, NXCD = 8, WGM = 8;
__device__ __forceinline__ int lds_byte(int r, int c) { const int st = (r >> 4) * 2 + (c >> 5), rr = r & 15, cc = c & 31, ob = rr * 64 + cc * 2; return st * 1024 + (ob ^ (((ob >> 9) & 1) << 5)); }
__device__ __forceinline__ void stage_rc(int b, int& R, int& C) { const int st = b / 1024, sb = b % 1024, swz = sb ^ (((sb >> 9) & 1) << 5); R = (st >> 1) * 16 + swz / 64; C = (st & 1) * 32 + (swz % 64) / 2; }
struct Unit { int pm, pn; };
struct Gemm { const bf16_t* A; const bf16_t* Bt; int M, N, K; };
struct StaticOrder {
  int nM, nN, nwg, G, c;
  __device__ void init(int M, int N, int G_, int c_) { nM = M / BM; nN = N / BM; nwg = nM * nN; G = G_; c = c_; }
  __device__ bool next(int i, Unit& u) const {
    const long L = (long)i * G + c; if (L >= nwg) return false;
    int wgid = (int)L; { const int q = nwg / NXCD, r = nwg % NXCD, xcd = wgid % NXCD, off = wgid / NXCD; wgid = (xcd < r ? xcd * (q + 1) : r * (q + 1) + (xcd - r) * q) + off; }
    const int nig = WGM * nN, gid = wgid / nig, fm = gid * WGM, gsz = (nM - fm) < WGM ? (nM - fm) : WGM;
    u.pm = fm + ((wgid % nig) % gsz); u.pn = (wgid % nig) / gsz; return true;
  }
};

template <class Epi>
__device__ __forceinline__ void gemm_phase(LAS unsigned char* lds, const Gemm g, const StaticOrder& S, const Epi& E) {
  const int tid = tid_opaque(), wid = __builtin_amdgcn_readfirstlane(tid >> 6), lane = tid & 63, wr = wid >> 2, wc = wid & 3, fr = lane & 15, fq = lane >> 4;
  const int K = g.K, nt = K / BK;
  unsigned voffA[2], voffB[2];
#pragma unroll
  for (int i = 0; i < 2; ++i) { int R, C; stage_rc(tid * 16 + i * 8192, R, C);
    voffA[i] = (unsigned)(R * K + C) * 2u; voffB[i] = voffA[i]; }
  const size_t kstep = (size_t)(BK * 2);
  const size_t hstep = (size_t)HALF * K * 2;
  const size_t tstep = 2 * hstep;
  const unsigned ldsw = (unsigned)wid * 1024u;
  const int aoff = lds_byte(wr * 64 + fr, fq * 8), boff = lds_byte(wc * 32 + fr, fq * 8);
#define PG8_SA(b, h) (((b) * 2 + (h)) * HTB)
#define PG8_SB(b, h) ((4 + (b) * 2 + (h)) * HTB)
#define PG8_STAGE(bufoff, gbase, voff) do { _Pragma("unroll") for (int _i = 0; _i < 2; ++_i) \
    __builtin_amdgcn_global_load_lds((const unsigned*)((const char*)(gbase) + (voff)[_i]), (LAS unsigned*)(lds + (bufoff) + ldsw + _i * 8192), 16, 0, 0); } while (0)
#define PG8_LDA(dst, b, h) do { _Pragma("unroll") for (int m = 0; m < 4; ++m) _Pragma("unroll") for (int k = 0; k < 2; ++k) dst[m][k] = *(const LAS bf16x8*)(lds + PG8_SA(b, h) + aoff + m * 2048 + k * 1024); } while (0)
#define PG8_LDB(dst, b, h) do { _Pragma("unroll") for (int n = 0; n < 2; ++n) _Pragma("unroll") for (int k = 0; k < 2; ++k) dst[n][k] = *(const LAS bf16x8*)(lds + PG8_SB(b, h) + boff + n * 2048 + k * 1024); } while (0)
#define PG8_MMA(ai, bj, At, Bt) do { __builtin_amdgcn_s_setprio(1); _Pragma("unroll") for (int m = 0; m < 4; ++m) _Pragma("unroll") for (int n = 0; n < 2; ++n) _Pragma("unroll") for (int k = 0; k < 2; ++k) \
    acc[ai][bj][m][n] = __builtin_amdgcn_mfma_f32_16x16x32_bf16(Bt[n][k], At[m][k], acc[ai][bj][m][n], 0, 0, 0); __builtin_amdgcn_s_setprio(0); } while (0)
#define PG8_WAIT_V(n) asm volatile("s_waitcnt vmcnt(" #n ")" ::: "memory")
#define PG8_WAIT_L(n) asm volatile("s_waitcnt lgkmcnt(" #n ")" ::: "memory")
#define PG8_BAR __builtin_amdgcn_s_barrier()
#define PG8_SCHED __builtin_amdgcn_sched_barrier(0)
  Unit cur, nxt; int ui = 0;
  if (!S.next(0, cur)) return;
  f32x4 acc[2][2][4][2];
#pragma unroll
  for (int a = 0; a < 2; ++a)
#pragma unroll
    for (int b = 0; b < 2; ++b)
#pragma unroll
      for (int m = 0; m < 4; ++m)
#pragma unroll
        for (int n = 0; n < 2; ++n) acc[a][b][m][n] = (f32x4){0.f, 0.f, 0.f, 0.f};
  bf16x8 At[4][2], B0[2][2], B1[2][2];
  const char* cA = (const char*)g.A + (size_t)cur.pm * tstep; const char* cB = (const char*)g.Bt + (size_t)cur.pn * tstep;
  PG8_STAGE(PG8_SB(0, 0), cB, voffB); PG8_STAGE(PG8_SA(0, 0), cA, voffA); PG8_STAGE(PG8_SB(0, 1), cB + hstep, voffB); PG8_STAGE(PG8_SA(0, 1), cA + hstep, voffA);
  if (wr == 1) PG8_BAR;
  PG8_WAIT_V(4); PG8_BAR;
  PG8_STAGE(PG8_SB(1, 0), cB + kstep, voffB); PG8_STAGE(PG8_SA(1, 0), cA + kstep, voffA); PG8_STAGE(PG8_SB(1, 1), cB + hstep + kstep, voffB);
  PG8_WAIT_V(6); PG8_BAR;
  for (;;) {
    const bool has_next = S.next(ui + 1, nxt);
    const char* nA = has_next ? (const char*)g.A + (size_t)nxt.pm * tstep : cA; const char* nB = has_next ? (const char*)g.Bt + (size_t)nxt.pn * tstep : cB;
    for (int t = 0; t < nt; t += 2) {
      const bool last = (t == nt - 2);
      const char* a1 = cA + (size_t)(t + 1) * kstep;
      const char* a2 = last ? nA : cA + (size_t)(t + 2) * kstep; const char* b2 = last ? nB : cB + (size_t)(t + 2) * kstep;
      const char* a3 = a2 + kstep; const char* b3 = b2 + kstep;
      PG8_LDB(B0, 0, 0); PG8_SCHED; PG8_LDA(At, 0, 0); PG8_STAGE(PG8_SA(1, 1), a1 + hstep, voffA);
      PG8_WAIT_L(8); PG8_BAR; PG8_WAIT_L(0); PG8_MMA(0, 0, At, B0); PG8_BAR; PG8_SCHED;
      PG8_LDB(B1, 0, 1); PG8_STAGE(PG8_SB(0, 0), b2, voffB);
      PG8_BAR; PG8_WAIT_L(0); PG8_MMA(0, 1, At, B1); PG8_BAR;
      PG8_LDA(At, 0, 1); PG8_STAGE(PG8_SA(0, 0), a2, voffA);
      PG8_BAR; PG8_WAIT_L(0); PG8_MMA(1, 0, At, B0); PG8_BAR; PG8_SCHED;
      PG8_STAGE(PG8_SB(0, 1), b2 + hstep, voffB);
      PG8_WAIT_V(6); PG8_BAR; PG8_MMA(1, 1, At, B1); PG8_BAR;
      PG8_LDB(B0, 1, 0); PG8_SCHED; PG8_LDA(At, 1, 0); PG8_STAGE(PG8_SA(0, 1), a2 + hstep, voffA);
      PG8_WAIT_L(8); PG8_BAR; PG8_WAIT_L(0); PG8_MMA(0, 0, At, B0); PG8_BAR; PG8_SCHED;
      PG8_LDB(B1, 1, 1); PG8_STAGE(PG8_SB(1, 0), b3, voffB);
      PG8_BAR; PG8_WAIT_L(0); PG8_MMA(0, 1, At, B1); PG8_BAR;
      PG8_LDA(At, 1, 1); PG8_STAGE(PG8_SA(1, 0), a3, voffA);
      PG8_BAR; PG8_WAIT_L(0); PG8_MMA(1, 0, At, B0); PG8_BAR; PG8_SCHED;
      PG8_STAGE(PG8_SB(1, 1), b3 + hstep, voffB);
      PG8_WAIT_V(6); PG8_BAR; PG8_MMA(1, 1, At, B1); PG8_BAR;
    }
    E(acc, cur, wr, wc, fr, fq);
    if (!has_next) break;
#pragma unroll
    for (int a = 0; a < 2; ++a)
#pragma unroll
      for (int b = 0; b < 2; ++b)
#pragma unroll
        for (int m = 0; m < 4; ++m)
#pragma unroll
          for (int n = 0; n < 2; ++n) acc[a][b][m][n] = (f32x4){0.f, 0.f, 0.f, 0.f};
    cur = nxt; cA = nA; cB = nB; ++ui;
  }
  PG8_WAIT_V(0);
  if (wr == 0) PG8_BAR;
  PG8_BAR;
#undef PG8_SA
#undef PG8_SB
#undef PG8_STAGE
#undef PG8_LDA
#undef PG8_LDB
#undef PG8_MMA
#undef PG8_WAIT_V
#undef PG8_WAIT_L
#undef PG8_BAR
#undef PG8_SCHED
}
}

typedef f32x4 AccT[2][2][4][2];
__device__ __forceinline__ int cond_of_pm(int pm) { return (pm < 32) ? 0 : 1 + ((pm - 32) >> 2); }

struct EpiResid {
  float* x; const float* gate; const float* rctx; const float* rlat;
  __device__ __forceinline__ void operator()(const AccT& acc, const pg8::Unit& u, int wr, int wc, int fr, int fq) const {
    const int row0 = u.pm * 256 + wr * 64 + fr, col0 = u.pn * 256 + wc * 32 + 4 * fq;
    const float* g = gate + (size_t)cond_of_pm(u.pm) * NMOD;
    f32x4 gv[2][2];
#pragma unroll
    for (int bj = 0; bj < 2; ++bj)
#pragma unroll
      for (int n = 0; n < 2; ++n) gv[bj][n] = *(const f32x4*)(g + col0 + bj * 128 + n * 16);
    const float* rbase = (u.pm < 32) ? rctx : rlat - (size_t)NCTX * DM;
#pragma unroll
    for (int ai = 0; ai < 2; ++ai) {
      f32x4 xv[4][2][2];
#pragma unroll
      for (int m = 0; m < 4; ++m)
#pragma unroll
        for (int bj = 0; bj < 2; ++bj)
#pragma unroll
          for (int n = 0; n < 2; ++n)
            xv[m][bj][n] = *(const f32x4*)(rbase + (size_t)(row0 + ai * 128 + m * 16) * DM + col0 + bj * 128 + n * 16);
#pragma unroll
      for (int m = 0; m < 4; ++m)
#pragma unroll
        for (int bj = 0; bj < 2; ++bj)
#pragma unroll
          for (int n = 0; n < 2; ++n)
            *(f32x4*)(x + (size_t)(row0 + ai * 128 + m * 16) * DM + col0 + bj * 128 + n * 16) = xv[m][bj][n] + gv[bj][n] * acc[ai][bj][m][n];
    }
  }
};
struct EpiSwiglu {
  bf16_t* u;
  __device__ __forceinline__ void operator()(const AccT& acc, const pg8::Unit& un, int wr, int wc, int fr, int fq) const {
    const int row0 = un.pm * 256 + wr * 64 + fr;
#pragma unroll
    for (int ai = 0; ai < 2; ++ai)
#pragma unroll
      for (int m = 0; m < 4; ++m) {
        bf16_t* rowp = u + (size_t)(row0 + ai * 128 + m * 16) * DFF;
#pragma unroll
        for (int bj = 0; bj < 2; ++bj) {
          const int col = 16 * (un.pn * 8 + bj * 4 + wc) + 4 * fq;
          const f32x4 a1 = acc[ai][bj][m][0], a3 = acc[ai][bj][m][1];
          u32x2 w;
          w.x = pack2(silu_f(a1[0]) * a3[0], silu_f(a1[1]) * a3[1]);
          w.y = pack2(silu_f(a1[2]) * a3[2], silu_f(a1[3]) * a3[3]);
          *(u32x2*)(rowp + col) = w;
        }
      }
  }
};
struct EpiGlu {
  float* x; const float* gate;
  __device__ __forceinline__ void operator()(const AccT& acc, const pg8::Unit& un, int wr, int wc, int fr, int fq) const {
    const int row0 = un.pm * 256 + wr * 64 + fr;
    const float* g = gate + (size_t)cond_of_pm(un.pm) * NMOD;
    f32x4 gv[2], xv[2][2][4];
#pragma unroll
    for (int bj = 0; bj < 2; ++bj) {
      const int col = 16 * (un.pn * 8 + bj * 4 + wc) + 4 * fq;
      gv[bj] = *(const f32x4*)(g + col);
#pragma unroll
      for (int ai = 0; ai < 2; ++ai)
#pragma unroll
        for (int m = 0; m < 4; ++m) xv[bj][ai][m] = *(const f32x4*)(x + (size_t)(row0 + ai * 128 + m * 16) * DM + col);
    }
#pragma unroll
    for (int bj = 0; bj < 2; ++bj) {
      const int col = 16 * (un.pn * 8 + bj * 4 + wc) + 4 * fq;
#pragma unroll
      for (int ai = 0; ai < 2; ++ai)
#pragma unroll
        for (int m = 0; m < 4; ++m) {
          const f32x4 val = acc[ai][bj][m][0], gt = acc[ai][bj][m][1];
          f32x4 o;
#pragma unroll
          for (int e = 0; e < 4; ++e) o[e] = val[e] * __builtin_amdgcn_rcpf(1.f + __expf(-gt[e]));
          *(f32x4*)(x + (size_t)(row0 + ai * 128 + m * 16) * DM + col) = xv[bj][ai][m] + gv[bj] * o;
        }
    }
  }
};
struct EpiQKV {
  const float* qg; const float* kg; bf16_t* q; bf16_t* k; bf16_t* v; float* nk; float* nv;
  __device__ __forceinline__ void operator()(const AccT& acc, const pg8::Unit& u, int wr, int wc, int fr, int fq) const {
    const int which = u.pn >> 2, hh = ((u.pn & 3) << 2) + wc;
    const int row0 = u.pm * 256 + wr * 64 + fr;
    const int cc0 = hh * 64 + 4 * fq;
    if (which < 2) {
      const float* gain = (which == 0) ? qg : kg;
      bf16_t* dstb = (which == 0) ? q : k;
      const float qscale = (which == 0) ? 0.125f * 1.4426950408889634f : 1.0f;
      f32x4 gn[2][2];
#pragma unroll
      for (int bj = 0; bj < 2; ++bj)
#pragma unroll
        for (int n = 0; n < 2; ++n) gn[bj][n] = *(const f32x4*)(gain + 32 * bj + 16 * n + 4 * fq);
#pragma unroll
      for (int ai = 0; ai < 2; ++ai)
#pragma unroll
        for (int m = 0; m < 4; ++m) {
          float ss = 0.f;
#pragma unroll
          for (int bj = 0; bj < 2; ++bj)
#pragma unroll
            for (int n = 0; n < 2; ++n) {
              const f32x4 a = acc[ai][bj][m][n];
              ss += a[0] * a[0] + a[1] * a[1] + a[2] * a[2] + a[3] * a[3];
            }
          ss += __shfl_xor(ss, 16); ss += __shfl_xor(ss, 32);
          const float rinv = 1.0f / sqrtf(ss * (1.f / 64.f) + 1e-6f);
          const int row = row0 + ai * 128 + m * 16;
#pragma unroll
          for (int bj = 0; bj < 2; ++bj)
#pragma unroll
            for (int n = 0; n < 2; ++n) {
              const f32x4 val = acc[ai][bj][m][n] * rinv * gn[bj][n];
              const int cc = cc0 + 32 * bj + 16 * n;
              const f32x4 vs = val * qscale;
              u32x2 w; w.x = pack2(vs[0], vs[1]); w.y = pack2(vs[2], vs[3]);
              *(u32x2*)(dstb + (size_t)row * DM + cc) = w;
              if (which == 1 && row < NCTX) {
                const int b = row >> 8, s = row & 255;
                __builtin_nontemporal_store(val, (f32x4*)(nk + ((size_t)b * 512 + s) * DM + cc));
              }
            }
        }
    } else {
#pragma unroll
      for (int ai = 0; ai < 2; ++ai)
#pragma unroll
        for (int m = 0; m < 4; ++m) {
          const int row = row0 + ai * 128 + m * 16;
#pragma unroll
          for (int bj = 0; bj < 2; ++bj)
#pragma unroll
            for (int n = 0; n < 2; ++n) {
              const f32x4 val = acc[ai][bj][m][n];
              const int cc = cc0 + 32 * bj + 16 * n;
              u32x2 w; w.x = pack2(val[0], val[1]); w.y = pack2(val[2], val[3]);
              *(u32x2*)(v + (size_t)row * DM + cc) = w;
              if (row < NCTX) {
                const int b = row >> 8, s = row & 255;
                __builtin_nontemporal_store(val, (f32x4*)(nv + ((size_t)b * 512 + s) * DM + cc));
              }
            }
        }
    }
  }
};

template <class Epi>
__device__ __forceinline__ void run_gemm(unsigned char* smem, const bf16_t* A, const bf16_t* Bt, int N, int K, const Epi& E) {
  pg8::Gemm g; g.A = A; g.Bt = Bt; g.M = NTOK; g.N = N; g.K = K;
  pg8::StaticOrder S; S.init(NTOK, N, (int)gridDim.x, (int)blockIdx.x);
  pg8::gemm_phase<Epi>((LAS unsigned char*)smem, g, S, E);
}

template <int NPAIR, bool LOCAL>
__device__ __forceinline__ void attn_chunk(const bf16_t* Ks, const bf16_t* Vs, const float* rpbs,
                                           const bf16x8 (&qf)[2], float& m, float& lsum, f32x4 (&oacc)[4],
                                           int l15, int q, int key_col0, int keyrow0_minus_r, int qc, int col_start) {
  constexpr int NT = 2 * NPAIR;
  f32x4 s[NT];
  float mx = -1e30f;
#pragma unroll
  for (int T = 0; T < NT; T++) {
    const int tstart = LOCAL ? ((T >> 1) * 64 + key_col0 + 16 * (T & 1)) : T * 16;
    f32x4 a4 = zero4();
#pragma unroll
    for (int ks = 0; ks < 2; ks++) {
      bf16x8 a = *(const bf16x8*)(Ks + (tstart + l15) * 72 + ks * 32 + q * 8);
      a4 = __builtin_amdgcn_mfma_f32_16x16x32_bf16(a, qf[ks], a4, 0, 0, 0);
    }
#pragma unroll
    for (int j = 0; j < 4; j++) {
      float v = a4[j];
      if (LOCAL) {
        const int kc = key_col0 + 16 * (T & 1) + 4 * q + j;
        const int dr = keyrow0_minus_r + (T >> 1);
        int dc = kc - qc; dc = dc < -15 ? -15 : (dc > 15 ? 15 : dc);
        const bool inwin = (kc >= col_start) && (kc < col_start + 16);
        v = inwin ? v + rpbs[(dr + 7) * 31 + dc + 15] : -1e30f;
      }
      a4[j] = v;
      mx = fmaxf(mx, v);
    }
    s[T] = a4;
  }
  mx = fmaxf(mx, __shfl_xor(mx, 16));
  mx = fmaxf(mx, __shfl_xor(mx, 32));
  const float mnew = fmaxf(m, mx);
  const float alpha = __builtin_amdgcn_exp2f(m - mnew);
  m = mnew;
  lsum *= alpha;
#pragma unroll
  for (int dt = 0; dt < 4; dt++)
#pragma unroll
    for (int j = 0; j < 4; j++) oacc[dt][j] *= alpha;
#pragma unroll
  for (int T = 0; T < NT; T++)
#pragma unroll
    for (int j = 0; j < 4; j++) {
      float pv = __builtin_amdgcn_exp2f(s[T][j] - mnew);
      lsum += pv;
      s[T][j] = pv;
    }
#pragma unroll
  for (int pp = 0; pp < NPAIR; pp++) {
    const int T0 = 2 * pp, T1 = 2 * pp + 1;
    const int ts0 = LOCAL ? (pp * 64 + key_col0) : T0 * 16;
    const int ts1 = ts0 + 16;
    union { bf16x8 v; unsigned u[4]; } pb;
    pb.u[0] = pack2(s[T0][0], s[T0][1]); pb.u[1] = pack2(s[T0][2], s[T0][3]);
    pb.u[2] = pack2(s[T1][0], s[T1][1]); pb.u[3] = pack2(s[T1][2], s[T1][3]);
    const bf16_t* vb0 = Vs + (ts0 + 4 * q + (l15 >> 2)) * 72 + 4 * (l15 & 3);
    const bf16_t* vb1 = Vs + (ts1 + 4 * q + (l15 >> 2)) * 72 + 4 * (l15 & 3);
#pragma unroll
    for (int dt = 0; dt < 4; dt++) {
      const s16x4 v0 = __builtin_amdgcn_ds_read_tr16_b64_v4i16((LAS s16x4*)(vb0 + dt * 16));
      const s16x4 v1 = __builtin_amdgcn_ds_read_tr16_b64_v4i16((LAS s16x4*)(vb1 + dt * 16));
      bf16x8 av;
      av[0] = v0[0]; av[1] = v0[1]; av[2] = v0[2]; av[3] = v0[3];
      av[4] = v1[0]; av[5] = v1[1]; av[6] = v1[2]; av[7] = v1[3];
      oacc[dt] = __builtin_amdgcn_mfma_f32_16x16x32_bf16(av, pb.v, oacc[dt], 0, 0, 0);
    }
  }
}

__device__ __forceinline__ void attn_src(bool lat, int b, int h, int jl, int row_start, int c,
                                         const bf16_t* Kb, const bf16_t* Vb, const bf16_t* CK, const bf16_t* CV,
                                         const bf16_t*& Ksrc, const bf16_t*& Vsrc, int& kstride) {
  if (!lat) {
    const size_t o = (size_t)(b * 256 + c * 128) * DM + h * 64;
    Ksrc = Kb + o; Vsrc = Vb + o; kstride = DM;
  } else if (c < 4) {
    const int kr0 = row_start + 2 * c;
    const size_t o = (size_t)(NCTX + b * 1024 + kr0 * 64) * DM + h * 64;
    Ksrc = Kb + o; Vsrc = Vb + o; kstride = DM;
  } else {
    const int cc = c - 4;
    const size_t o = ((size_t)((b * 2 + jl) * 16 + h) * 512 + cc * 128) * 64;
    Ksrc = CK + o; Vsrc = CV + o; kstride = 64;
  }
}

__device__ void attn_phase(const Params& p, int jl, unsigned char* smem) {
  const int t = tid_opaque();
  const int hb = t >> 8, tl = t & 255;
  bf16_t* Ks = (bf16_t*)(smem + hb * HALF_LDS);
  bf16_t* Vs = Ks + 128 * 72;
  float* rpbs = (float*)(Vs + 128 * 72);
  const bf16_t* Qb = (const bf16_t*)(p.ws + WS_Q);
  const bf16_t* Kb = (const bf16_t*)(p.ws + WS_K);
  const bf16_t* Vb = (const bf16_t*)(p.ws + WS_V);
  const bf16_t* CK = (const bf16_t*)(p.ws + WS_CK);
  const bf16_t* CV = (const bf16_t*)(p.ws + WS_CV);
  bf16_t* Ob = (bf16_t*)(p.ws + WS_O);
  const int lane = tl & 63, w = tl >> 6, l15 = lane & 15, q = lane >> 4;
  const int lkey = tl >> 3, ld8 = (tl & 7) * 8;
  for (int pi = blockIdx.x; pi < 1280; pi += gridDim.x) {
    const int it = pi * 2 + hb;
    const bool lat = pi < 256;
    int b, h, r = 0, token, row_start = 0, key_col0 = 0, qc = 0, col_start = 0;
    if (lat) {
      b = it >> 8; h = (it >> 4) & 15; r = it & 15;
      token = NCTX + b * 1024 + r * 64 + w * 16 + l15;
      row_start = r - 4; row_start = row_start < 0 ? 0 : (row_start > 8 ? 8 : row_start);
      key_col0 = 16 * w - 8; key_col0 = key_col0 < 0 ? 0 : (key_col0 > 32 ? 32 : key_col0);
      qc = 16 * w + l15;
      col_start = qc - 8; col_start = col_start < 0 ? 0 : (col_start > 48 ? 48 : col_start);
    } else {
      const int i2 = it - 512;
      b = i2 >> 6; h = (i2 >> 2) & 15; const int qb = i2 & 3;
      token = b * 256 + qb * 64 + w * 16 + l15;
    }
    const int nch = lat ? 8 : 2;
    u32x4 rk0, rk1, rk2, rk3, rv0, rv1, rv2, rv3;
    {
      const bf16_t* Ksrc; const bf16_t* Vsrc; int kstride;
      attn_src(lat, b, h, jl, row_start, 0, Kb, Vb, CK, CV, Ksrc, Vsrc, kstride);
      const bf16_t* kp = Ksrc + (size_t)lkey * kstride + ld8; const bf16_t* vp = Vsrc + (size_t)lkey * kstride + ld8;
      rk0 = *(const u32x4*)(kp); rk1 = *(const u32x4*)(kp + (size_t)32 * kstride); rk2 = *(const u32x4*)(kp + (size_t)64 * kstride); rk3 = *(const u32x4*)(kp + (size_t)96 * kstride);
      rv0 = *(const u32x4*)(vp); rv1 = *(const u32x4*)(vp + (size_t)32 * kstride); rv2 = *(const u32x4*)(vp + (size_t)64 * kstride); rv3 = *(const u32x4*)(vp + (size_t)96 * kstride);
    }
    bf16x8 qf[2];
    qf[0] = *(const bf16x8*)(Qb + (size_t)token * DM + h * 64 + q * 8);
    qf[1] = *(const bf16x8*)(Qb + (size_t)token * DM + h * 64 + 32 + q * 8);
    float m = -1e30f, lsum = 0.f;
    f32x4 oacc[4];
#pragma unroll
    for (int dt = 0; dt < 4; dt++) oacc[dt] = zero4();
    for (int c = 0; c < nch; c++) {
      __syncthreads();
      *(u32x4*)(Ks + (lkey + 0) * 72 + ld8) = rk0; *(u32x4*)(Ks + (lkey + 32) * 72 + ld8) = rk1;
      *(u32x4*)(Ks + (lkey + 64) * 72 + ld8) = rk2; *(u32x4*)(Ks + (lkey + 96) * 72 + ld8) = rk3;
      *(u32x4*)(Vs + (lkey + 0) * 72 + ld8) = rv0; *(u32x4*)(Vs + (lkey + 32) * 72 + ld8) = rv1;
      *(u32x4*)(Vs + (lkey + 64) * 72 + ld8) = rv2; *(u32x4*)(Vs + (lkey + 96) * 72 + ld8) = rv3;
      if (lat && c == 0) {
        for (int i = tl; i < 465; i += 256) rpbs[i] = p.rpb[(size_t)(jl * 16 + h) * 465 + i] * 1.4426950408889634f;
      }
      __syncthreads();
      if (c + 1 < nch) {
        const bf16_t* Ksrc; const bf16_t* Vsrc; int kstride;
        attn_src(lat, b, h, jl, row_start, c + 1, Kb, Vb, CK, CV, Ksrc, Vsrc, kstride);
        const bf16_t* kp = Ksrc + (size_t)lkey * kstride + ld8; const bf16_t* vp = Vsrc + (size_t)lkey * kstride + ld8;
        rk0 = *(const u32x4*)(kp); rk1 = *(const u32x4*)(kp + (size_t)32 * kstride); rk2 = *(const u32x4*)(kp + (size_t)64 * kstride); rk3 = *(const u32x4*)(kp + (size_t)96 * kstride);
        rv0 = *(const u32x4*)(vp); rv1 = *(const u32x4*)(vp + (size_t)32 * kstride); rv2 = *(const u32x4*)(vp + (size_t)64 * kstride); rv3 = *(const u32x4*)(vp + (size_t)96 * kstride);
      }
      if (lat && c < 4) {
        attn_chunk<2, true>(Ks, Vs, rpbs, qf, m, lsum, oacc, l15, q, key_col0, row_start + 2 * c - r, qc, col_start);
      } else {
        attn_chunk<4, false>(Ks, Vs, rpbs, qf, m, lsum, oacc, l15, q, 0, 0, 0, 0);
      }
    }
    lsum += __shfl_xor(lsum, 16);
    lsum += __shfl_xor(lsum, 32);
    const float inv = 1.f / lsum;
#pragma unroll
    for (int dt = 0; dt < 4; dt++) {
      uint2 pk = make_uint2(pack2(oacc[dt][0] * inv, oacc[dt][1] * inv), pack2(oacc[dt][2] * inv, oacc[dt][3] * inv));
      *(uint2*)(Ob + (size_t)token * DM + h * 64 + dt * 16 + q * 4) = pk;
    }
  }
}

#define WAVE_SYNC() do { asm volatile("s_waitcnt lgkmcnt(0)" ::: "memory"); __builtin_amdgcn_wave_barrier(); asm volatile("" ::: "memory"); } while (0)
__device__ __forceinline__ float bf_lo(float x, unsigned hi_bits16) { return x - __uint_as_float(hi_bits16 << 16); }

__device__ void s5_phase(const Params& p, int jl, unsigned char* smem) {
  const int t = tid_opaque();
  const int lane = t & 63, w = t >> 6, l15 = lane & 15, q = lane >> 4;
  float* BuS = (float*)(smem + w * 17408);
  unsigned* XsH = (unsigned*)(BuS + 16 * 132);
  unsigned* XsL = XsH + 16 * 68;
  const float* HF = (const float*)(p.ws + WS_HF);
  bf16_t* YF = (bf16_t*)(p.ws + WS_YF);
  bf16_t* YB = (bf16_t*)(p.ws + WS_YB);
  const float4* DISC = (const float4*)(p.ws + WS_DISC);
  const bool latw = (w == 0);
  int it = latw ? (int)blockIdx.x : (w - 1) * (int)gridDim.x + (int)blockIdx.x;
  int itstep = latw ? (int)gridDim.x : (int)gridDim.x * 7;
  int itend = latw ? 256 : 4096;
  if (gridDim.x == 256 && !latw) {
    const int start = (w < 4) ? (w - 1) * 3 : (w == 4 ? 15 : 9 + (w - 5) * 2);
    const int cnt = (w < 4) ? 3 : (w == 4 ? 1 : 2);
    it = (int)blockIdx.x * 16 + start; itstep = 1; itend = it + cnt;
  }
  for (; it < itend; it += itstep) {
    const bool lat = latw;
    const int bt = lat ? 32 + (it >> 7) : (it >> 7);
    const int rest = it & 127;
    const int dir = rest >> 6, g = rest & 63;
    const int L = lat ? 1024 : 256;
    const int tokbase = lat ? NCTX + (bt - 32) * 1024 : bt * 256;
    const int pg = (jl * 2 + dir) * 64 + g;
    bf16x8 Bh[8];
    {
      const int c0 = 8 * (q & 1);
#pragma unroll
      for (int nn = 0; nn < 4; nn++) {
        const int ps = 16 * nn + l15;
        const float4 dd = DISC[pg * 64 + ps];
        const float fre = dd.z, fim = dd.w;
        const float4 br0 = *(const float4*)(p.b_re + (size_t)(pg * 64 + ps) * 16 + c0);
        const float4 br1 = *(const float4*)(p.b_re + (size_t)(pg * 64 + ps) * 16 + c0 + 4);
        const float4 bi0 = *(const float4*)(p.b_im + (size_t)(pg * 64 + ps) * 16 + c0);
        const float4 bi1 = *(const float4*)(p.b_im + (size_t)(pg * 64 + ps) * 16 + c0 + 4);
        float vr[8], vi[8];
        vr[0] = fre * br0.x - fim * bi0.x; vi[0] = fre * bi0.x + fim * br0.x;
        vr[1] = fre * br0.y - fim * bi0.y; vi[1] = fre * bi0.y + fim * br0.y;
        vr[2] = fre * br0.z - fim * bi0.z; vi[2] = fre * bi0.z + fim * br0.z;
        vr[3] = fre * br0.w - fim * bi0.w; vi[3] = fre * bi0.w + fim * br0.w;
        vr[4] = fre * br1.x - fim * bi1.x; vi[4] = fre * bi1.x + fim * br1.x;
        vr[5] = fre * br1.y - fim * bi1.y; vi[5] = fre * bi1.y + fim * br1.y;
        vr[6] = fre * br1.z - fim * bi1.z; vi[6] = fre * bi1.z + fim * br1.z;
        vr[7] = fre * br1.w - fim * bi1.w; vi[7] = fre * bi1.w + fim * br1.w;
        union { bf16x8 v; unsigned u[4]; } hr, hi;
#pragma unroll
        for (int e = 0; e < 4; e++) {
          hr.u[e] = pack2(vr[2 * e], vr[2 * e + 1]);
          hi.u[e] = pack2(vi[2 * e], vi[2 * e + 1]);
        }
        Bh[nn] = hr.v; Bh[4 + nn] = hi.v;
      }
    }
    bf16x8 Ch[4];
    {
      const float* cr = p.c_re + ((size_t)pg * 16 + l15) * 64 + 4 * q;
      const float* ci = p.c_im + ((size_t)pg * 16 + l15) * 64 + 4 * q;
#pragma unroll
      for (int kk = 0; kk < 4; kk++) {
        const float4 a = *(const float4*)(cr + 16 * kk);
        const float4 b = *(const float4*)(ci + 16 * kk);
        float v[8] = {a.x, -b.x, a.y, -b.y, a.z, -b.z, a.w, -b.w};
        union { bf16x8 v; unsigned u[4]; } h;
#pragma unroll
        for (int e = 0; e < 4; e++) h.u[e] = pack2(v[2 * e], v[2 * e + 1]);
        Ch[kk] = h.v;
      }
    }
    const float4 dme = DISC[pg * 64 + lane];
    const float a_re = dme.x, a_im = dme.y;
    float xr = 0.f, xi = 0.f;
    if (lat) {
      const size_t sidx = ((size_t)(((bt - 32) * 2 + jl) * 2 + dir) * 64 + g) * 64 + lane;
      xr = p.st_re[sidx]; xi = p.st_im[sidx];
    }
    const int nch = L >> 4;
    const float* ubase = HF + (size_t)(tokbase + l15) * DM + g * 16 + 8 * (q & 1);
    bf16_t* ybase = (dir ? YB : YF) + (size_t)(tokbase + l15) * DM + g * 16 + 4 * q;
    const float* usk = HF + (size_t)(tokbase + l15) * DM + g * 16 + 4 * q;
    float4 dsk4 = *(const float4*)(p.ssm_d + (size_t)jl * DM + g * 16 + 4 * q);
    if (dir) dsk4 = make_float4(0.f, 0.f, 0.f, 0.f);
    const int t00 = dir ? L - 16 : 0;
    const int tstep = dir ? -16 : 16;
    float4 ra0 = *(const float4*)(ubase + (size_t)t00 * DM),               ra1 = *(const float4*)(ubase + (size_t)t00 * DM + 4);
    float4 rb0 = *(const float4*)(ubase + (size_t)(t00 + tstep) * DM),     rb1 = *(const float4*)(ubase + (size_t)(t00 + tstep) * DM + 4);
    float4 rc0 = *(const float4*)(ubase + (size_t)(t00 + 2 * tstep) * DM), rc1 = *(const float4*)(ubase + (size_t)(t00 + 2 * tstep) * DM + 4);
    for (int ci = 0; ci < nch; ci++) {
      const int t0 = dir ? L - 16 * (ci + 1) : 16 * ci;
      const float4 u0 = ra0, u1 = ra1;
      const float4 usk4 = *(const float4*)(usk + (size_t)t0 * DM);
      ra0 = rb0; ra1 = rb1; rb0 = rc0; rb1 = rc1;
      if (ci + 3 < nch) {
        const int t0n = t0 + 3 * tstep;
        rc0 = *(const float4*)(ubase + (size_t)t0n * DM);
        rc1 = *(const float4*)(ubase + (size_t)t0n * DM + 4);
      }
      union { bf16x8 v; unsigned u[4]; } uh, ul;
      uh.u[0] = pack2(u0.x, u0.y); uh.u[1] = pack2(u0.z, u0.w); uh.u[2] = pack2(u1.x, u1.y); uh.u[3] = pack2(u1.z, u1.w);
      ul.u[0] = pack2(bf_lo(u0.x, uh.u[0] & 0xffffu), bf_lo(u0.y, uh.u[0] >> 16));
      ul.u[1] = pack2(bf_lo(u0.z, uh.u[1] & 0xffffu), bf_lo(u0.w, uh.u[1] >> 16));
      ul.u[2] = pack2(bf_lo(u1.x, uh.u[2] & 0xffffu), bf_lo(u1.y, uh.u[2] >> 16));
      ul.u[3] = pack2(bf_lo(u1.z, uh.u[3] & 0xffffu), bf_lo(u1.w, uh.u[3] >> 16));
      const bf16x8 uf = (q < 2) ? uh.v : ul.v;
      f32x4 d[8];
#pragma unroll
      for (int n = 0; n < 8; n++) d[n] = __builtin_amdgcn_mfma_f32_16x16x32_bf16(Bh[n], uf, zero4(), 0, 0, 0);
      WAVE_SYNC();
#pragma unroll
      for (int n = 0; n < 8; n++) *(f32x4*)(BuS + l15 * 132 + 16 * n + 4 * q) = d[n];
      WAVE_SYNC();
      float bur[16], bui[16];
#pragma unroll
      for (int s = 0; s < 16; s++) {
        const int rr = dir ? 15 - s : s;
        bur[s] = BuS[rr * 132 + lane];
        bui[s] = BuS[rr * 132 + 64 + lane];
      }
      __builtin_amdgcn_sched_barrier(0);
#pragma unroll
      for (int s = 0; s < 16; s++) {
        const int rr = dir ? 15 - s : s;
        const float nxr = a_re * xr - a_im * xi + bur[s];
        const float nxi = a_re * xi + a_im * xr + bui[s];
        xr = nxr; xi = nxi;
        XsH[rr * 68 + lane] = pack2(xr, xi);
      }
      WAVE_SYNC();
      f32x4 acc0 = zero4(), acc1 = zero4();
#pragma unroll
      for (int kk = 0; kk < 4; kk++) {
        const bf16x8 xh = *(const bf16x8*)(XsH + l15 * 68 + 16 * kk + 4 * q);
        if (kk & 1) acc1 = __builtin_amdgcn_mfma_f32_16x16x32_bf16(Ch[kk], xh, acc1, 0, 0, 0);
        else        acc0 = __builtin_amdgcn_mfma_f32_16x16x32_bf16(Ch[kk], xh, acc0, 0, 0, 0);
      }
      const f32x4 acc2 = zero4();
      {
        const f32x4 yv = acc0 + (acc1 + acc2);
        u32x2 yw;
        yw.x = pack2(yv[0] + dsk4.x * usk4.x, yv[1] + dsk4.y * usk4.y);
        yw.y = pack2(yv[2] + dsk4.z * usk4.z, yv[3] + dsk4.w * usk4.w);
        *(u32x2*)(ybase + (size_t)t0 * DM) = yw;
      }
    }
    if (!lat) {
      const size_t oidx = ((size_t)((bt * 2 + jl) * 2 + dir) * 64 + g) * 64 + lane;
      p.out[OUT_SRE + oidx] = xr;
      p.out[OUT_SIM + oidx] = xi;
    }
  }
}

__device__ void combine_phase(const Params& p, int jl) {
  const u32x2* YF = (const u32x2*)(p.ws + WS_YF);
  const u32x2* YB = (const u32x2*)(p.ws + WS_YB);
  u32x2* Z = (u32x2*)(p.ws + WS_H);
  const size_t n4 = (size_t)NTOK * DM / 4;
  const int t_ = tid_opaque();
  for (size_t i = (size_t)blockIdx.x * 512 + t_; i < n4; i += (size_t)gridDim.x * 512) {
    const u32x2 a = YF[i], b = YB[i];
    const float y0 = __uint_as_float(a.x << 16) + __uint_as_float(b.x << 16);
    const float y1 = __uint_as_float(a.x & 0xffff0000u) + __uint_as_float(b.x & 0xffff0000u);
    const float y2 = __uint_as_float(a.y << 16) + __uint_as_float(b.y << 16);
    const float y3 = __uint_as_float(a.y & 0xffff0000u) + __uint_as_float(b.y & 0xffff0000u);
    u32x2 z; z.x = pack2(gelu_tanh(y0), gelu_tanh(y1)); z.y = pack2(gelu_tanh(y2), gelu_tanh(y3));
    Z[i] = z;
  }
}

#define XB_TMO      128
#define XB_XCNT(j)  (256  + 64 * (j))
#define XB_XSUB(j)  (1280 + 64 * (j))
#define XB_XGEN(j)  (2304 + 64 * (j))
#define XB_TOP      3328
#define XB_TOPGEN   3392
#define XCD_BAR_WORDS 3456
#define XB_SPIN_CAP (1u << 22)

__device__ __forceinline__ unsigned xb_ld(unsigned* p)              { return __hip_atomic_load(p, __ATOMIC_RELAXED, __HIP_MEMORY_SCOPE_AGENT); }
__device__ __forceinline__ unsigned xb_add(unsigned* p, unsigned v) { return __hip_atomic_fetch_add(p, v, __ATOMIC_RELAXED, __HIP_MEMORY_SCOPE_AGENT); }
__device__ __forceinline__ unsigned xb_xcc_id() { return (unsigned)__builtin_amdgcn_s_getreg((3 << 11) | 20) & 0xFu; }
#define XB_SPIN(cond, bar) do { unsigned _sp = 0; while (cond) { __builtin_amdgcn_s_sleep(1); \
    if ((++_sp & 255u) == 0u) { if (xb_ld(&(bar)[XB_TMO])) break; if (_sp > XB_SPIN_CAP) { atomicAdd(&(bar)[XB_TMO], 1u); break; } } } } while (0)

struct XcdBarrier { unsigned* bar; unsigned x; volatile LAS unsigned* st; };

__device__ __forceinline__ XcdBarrier xcd_barrier_post(unsigned* bar, volatile LAS unsigned* st) {
  XcdBarrier b; b.bar = bar; b.x = xb_xcc_id(); b.st = st;
  if (threadIdx.x == 0) (void)xb_add(&bar[XB_XCNT(b.x)], 1u);
  return b;
}
__device__ __forceinline__ void xcd_barrier_complete(unsigned* bar, unsigned x, unsigned& nloc, unsigned& nx) {
  const unsigned G = gridDim.x * gridDim.y * gridDim.z;
  unsigned sum, cnt, mine, sp = 0u;
  for (;;) {
    sum = 0u; cnt = 0u; mine = 0u;
#pragma unroll
    for (unsigned j = 0; j < 16; ++j) { const unsigned c = xb_ld(&bar[XB_XCNT(j)]); sum += c; cnt += (c > 0u) ? 1u : 0u; mine = (j == x) ? c : mine; }
    if (sum == G) break;
    __builtin_amdgcn_s_sleep(1);
    if ((++sp & 255u) == 0u) { if (xb_ld(&bar[XB_TMO])) break; if (sp > XB_SPIN_CAP) { atomicAdd(&bar[XB_TMO], 1u); break; } }
  }
  nloc = mine > 0u ? mine : 1u; nx = cnt > 0u ? cnt : 1u;
}
__device__ __forceinline__ void xcd_barrier(unsigned* bar_, volatile LAS unsigned* st_) {
  XcdBarrier b; b.bar = bar_; b.x = xb_xcc_id(); b.st = st_;
  asm volatile("s_waitcnt vmcnt(0)" ::: "memory");
  __syncthreads();
  if (threadIdx.x == 0) {
    unsigned* bar = b.bar;
    __builtin_amdgcn_s_waitcnt(0);
    unsigned nloc = b.st[0], nx = b.st[1];
    if (nloc == 0u) { xcd_barrier_complete(bar, b.x, nloc, nx); b.st[0] = nloc; b.st[1] = nx; }
    const unsigned old = xb_add(&bar[XB_XSUB(b.x)], 1u);
    const unsigned gen = old / nloc;
    if (old + 1u == (gen + 1u) * nloc) {
      __builtin_amdgcn_fence(__ATOMIC_RELEASE, "agent");
      asm volatile("s_waitcnt vmcnt(0)" ::: "memory");
      const unsigned og = xb_add(&bar[XB_TOP], 1u);
      const unsigned tg = og / nx;
      if (og + 1u == (tg + 1u) * nx) xb_add(&bar[XB_TOPGEN], 1u);
      else XB_SPIN(xb_ld(&bar[XB_TOPGEN]) == tg, bar);
      __builtin_amdgcn_fence(__ATOMIC_ACQUIRE, "agent");
      xb_add(&bar[XB_XGEN(b.x)], 1u);
      asm volatile("s_waitcnt vmcnt(0)" ::: "memory");
    } else {
      XB_SPIN(xb_ld(&bar[XB_XGEN(b.x)]) == gen, bar);
      __builtin_amdgcn_fence(__ATOMIC_ACQUIRE, "agent");
      asm volatile("s_waitcnt vmcnt(0)" ::: "memory");
    }
  }
  __syncthreads();
}

__global__ void __launch_bounds__(512, 2) mega_kernel(Params p) {
  extern __shared__ __attribute__((aligned(16))) unsigned char smem[];
  cg::grid_group grid = cg::this_grid();
  if (threadIdx.x == 0) *(uint4*)(smem + SMEM_BAR) = make_uint4(0u, 0u, 0u, 0u);
  __syncthreads();
  (void)xcd_barrier_post((unsigned*)(p.ws + WS_BAR), (volatile LAS unsigned*)(smem + SMEM_BAR));
#define GSYNC() xcd_barrier((unsigned*)(p.ws + WS_BAR), (volatile LAS unsigned*)(smem + SMEM_BAR))
  if (p.ws == nullptr) grid.sync();
  const float* mod = (const float*)(p.ws + WS_MOD);
  bf16_t* H = (bf16_t*)(p.ws + WS_H);
  float* X = p.out + OUT_X;

  if ((int)gridDim.x == 256) {
    if ((int)blockIdx.x < 96) ada_stage(p, smem, 0, (int)blockIdx.x, 96);
    else prep_items(p, smem, 0, (int)blockIdx.x - 96, 160, 0);
  } else {
    prep_items(p, smem, 0, (int)blockIdx.x, (int)gridDim.x, 2);
  }
  GSYNC();

#pragma unroll 1
  for (int i = 0; i < 4; i++) {
    const int jl = i >> 1;
    const bool ssm = (i & 1);
    const float* modl = mod + (size_t)i * 3 * NMOD;
    if (i == 0)
      norm_phase(p.x_prompt, p.x_sample, p.norm_mix + i * DM, modl, 0, H, nullptr, nullptr);
    else
      norm_phase(X, X + (size_t)NCTX * DM, p.norm_mix + i * DM, modl, 0, ssm ? nullptr : H, ssm ? (float*)(p.ws + WS_HF) : nullptr, nullptr);
    GSYNC();
    if (!ssm) {
      EpiQKV eq;
      eq.qg = p.q_gain + jl * 64; eq.kg = p.k_gain + jl * 64;
      eq.q = (bf16_t*)(p.ws + WS_Q); eq.k = (bf16_t*)(p.ws + WS_K); eq.v = (bf16_t*)(p.ws + WS_V);
      eq.nk = p.out + OUT_NK + (size_t)jl * 256 * DM; eq.nv = p.out + OUT_NV + (size_t)jl * 256 * DM;
      run_gemm(smem, H, (const bf16_t*)(p.ws + WS_WQKV) + (size_t)jl * 3072 * 1024, 3072, 1024, eq);
      GSYNC();
      attn_phase(p, jl, smem);
      GSYNC();
      EpiResid er; er.x = X; er.gate = modl + 2 * 1024;
      er.rctx = (i == 0) ? p.x_prompt : X; er.rlat = (i == 0) ? p.x_sample : X + (size_t)NCTX * DM;
      run_gemm(smem, (const bf16_t*)(p.ws + WS_O), (const bf16_t*)(p.ws + WS_WO) + (size_t)jl * 1024 * 1024, 1024, 1024, er);
      if (i == 0 && (int)blockIdx.x >= 160 && (int)gridDim.x == 256)
        prep_items(p, smem, 0, (int)blockIdx.x - 160, (int)gridDim.x - 160, 1);
      GSYNC();
    } else {
      s5_phase(p, jl, smem);
      GSYNC();
      combine_phase(p, jl);
      GSYNC();
      EpiGlu eg; eg.x = X; eg.gate = modl + 2 * 1024;
      run_gemm(smem, H, (const bf16_t*)(p.ws + WS_WGLU) + (size_t)jl * 2048 * 1024, 2048, 1024, eg);
      GSYNC();
    }
    norm_phase(X, X + (size_t)NCTX * DM, p.norm_ffn + i * DM, modl, 3, H, nullptr, nullptr);
    GSYNC();
    EpiSwiglu es; es.u = (bf16_t*)(p.ws + WS_U);
    run_gemm(smem, H, (const bf16_t*)(p.ws + WS_W13) + (size_t)i * 5632 * 1024, 5632, 1024, es);
    if (i < 3 && (int)gridDim.x == 256 && (int)blockIdx.x >= 112)
      ada_stage(p, smem, i + 1, (int)blockIdx.x - 112, 144);
    GSYNC();
    EpiResid ed; ed.x = X; ed.gate = modl + 5 * 1024; ed.rctx = X; ed.rlat = X + (size_t)NCTX * DM;
    run_gemm(smem, (const bf16_t*)(p.ws + WS_U), (const bf16_t*)(p.ws + WS_W2) + (size_t)i * 1024 * DFF, 1024, DFF, ed);
    if (i < 3 && (int)blockIdx.x >= 160 && (int)gridDim.x > 160)
      prep_items(p, smem, i + 1, (int)blockIdx.x - 160, (int)gridDim.x - 160, 2);
    GSYNC();
  }
}

extern "C" void kernel_launch(void* const* d_in, const int* in_sizes, int n_in, void* d_out, int out_size,
                              void* d_ws, size_t ws_size, hipStream_t stream) {
  static int grid_blocks = 0;
  if (!grid_blocks) {
    int dev = 0, cus = 0, per_cu = 0;
    (void)hipGetDevice(&dev);
    (void)hipDeviceGetAttribute(&cus, hipDeviceAttributeMultiprocessorCount, dev);
    (void)hipFuncSetAttribute((const void*)mega_kernel, hipFuncAttributeMaxDynamicSharedMemorySize, SMEM_BYTES);
    (void)hipOccupancyMaxActiveBlocksPerMultiprocessor(&per_cu, mega_kernel, 512, SMEM_BYTES);
    if (per_cu > 1) per_cu = 1;
    if (per_cu < 1) per_cu = 1;
    grid_blocks = cus * per_cu;
  }
  if (ws_size < WS_END) { fprintf(stderr, "workspace too small: %zu < %zu\n", ws_size, (size_t)WS_END); return; }
  Params p{};
  const float** pp = (const float**)&p;
  for (int i = 0; i < 29; i++) pp[i] = (const float*)d_in[i];
  p.out = (float*)d_out;
  p.ws = (unsigned char*)d_ws;
  (void)hipMemsetAsync((unsigned char*)d_ws + WS_BAR, 0, XCD_BAR_WORDS * 4, stream);
  void* args[] = {&p};
  hipError_t err = hipLaunchCooperativeKernel((void*)mega_kernel, dim3(grid_blocks), dim3(512), args, SMEM_BYTES, stream);
  if (err != hipSuccess) fprintf(stderr, "cooperative launch failed: %s (grid %d)\n", hipGetErrorString(err), grid_blocks);
}
```

```cpp
#include <hip/hip_runtime.h>
#include <hip/hip_cooperative_groups.h>
#include <cstdio>
#include <cstdint>
namespace cg = cooperative_groups;

typedef unsigned short bf16_t;
typedef __attribute__((ext_vector_type(8))) short bf16x8;
typedef __attribute__((ext_vector_type(4))) short s16x4;
typedef __attribute__((ext_vector_type(4))) float f32x4;
typedef __attribute__((ext_vector_type(4))) unsigned u32x4;
typedef __attribute__((ext_vector_type(2))) unsigned u32x2;
#define LAS __attribute__((address_space(3)))

constexpr int DM = 1024;
constexpr int NCTX = 8192;
constexpr int NLAT = 2048;
constexpr int NTOK = 10240;
constexpr int DFF = 2816;
constexpr int NMOD = 6144;

constexpr size_t OUT_X   = 0;
constexpr size_t OUT_NK  = 10485760;
constexpr size_t OUT_NV  = 27262976;
constexpr size_t OUT_SRE = 44040192;
constexpr size_t OUT_SIM = 44564480;

constexpr size_t WS_WQKV = 0;
constexpr size_t WS_WO   = WS_WQKV + 12582912;
constexpr size_t WS_WGLU = WS_WO   + 4194304;
constexpr size_t WS_W13  = WS_WGLU + 8388608;
constexpr size_t WS_W2   = WS_W13  + 46137344;
constexpr size_t WS_MOD  = WS_W2   + 23068672;
constexpr size_t WS_CK   = WS_MOD  + 294912;
constexpr size_t WS_CV   = WS_CK   + 4194304;
constexpr size_t WS_H    = WS_CV   + 4194304;
constexpr size_t WS_R    = WS_H    + 20971520;
constexpr size_t WS_Q    = WS_R;
constexpr size_t WS_K    = WS_Q + 20971520;
constexpr size_t WS_V    = WS_K + 20971520;
constexpr size_t WS_O    = WS_V + 20971520;
constexpr size_t WS_U    = WS_R;
constexpr size_t WS_HF   = WS_R;
constexpr size_t WS_YF   = WS_HF + 41943040;
constexpr size_t WS_YB   = WS_YF + 41943040;
constexpr size_t WS_BAR  = WS_R + 125829120;
constexpr size_t WS_DISC = WS_BAR + 16384;
constexpr size_t WS_END  = WS_DISC + 262144;

constexpr int SMEM_STAGE = 131072;
constexpr int SMEM_BYTES = 147456 + 64;
constexpr int SMEM_BAR = 147456;
constexpr int HALF_LDS = 40960;

struct Params {
  const float *x_prompt, *x_sample, *cache_k, *cache_v, *st_re, *st_im, *c, *c_ctx;
  const float *norm_mix, *norm_ffn, *ada_w, *ada_b, *w_qkv, *w_o, *q_gain, *k_gain, *rpb;
  const float *lam_re, *lam_im, *log_step, *b_re, *b_im, *c_re, *c_im, *ssm_d, *w_glu, *w1, *w3, *w2;
  float* out;
  unsigned char* ws;
};

__device__ __forceinline__ unsigned f2bf(float f) {
  unsigned u = __float_as_uint(f);
  u += 0x7fffu + ((u >> 16) & 1u);
  return u >> 16;
}
typedef __bf16 bf16n2 __attribute__((ext_vector_type(2)));
typedef float f32x2 __attribute__((ext_vector_type(2)));
__device__ __forceinline__ unsigned pack2(float a, float b) { f32x2 v = {a, b}; bf16n2 r = __builtin_convertvector(v, bf16n2); return __builtin_bit_cast(unsigned, r); }
__device__ __forceinline__ float silu_f(float x) { return x * __builtin_amdgcn_rcpf(1.f + __expf(-x)); }
__device__ __forceinline__ float gelu_tanh(float y) {
  float a = 1.5957691216057308f * (y + 0.044715f * y * y * y);
  return y * __builtin_amdgcn_rcpf(1.f + __expf(-a));
}
__device__ __forceinline__ int tid_opaque() { int t = threadIdx.x; asm volatile("" : "+v"(t)); return t; }
__device__ __forceinline__ f32x4 zero4() { f32x4 z = {0.f, 0.f, 0.f, 0.f}; return z; }

__device__ __forceinline__ int map_row(int n, int mode, int off) {
  if (mode == 0) return n;
  if (mode == 1) return (n >> 4) * 32 + off + (n & 15);
  const int np = n & 255;
  return (n & ~255) + 128 * ((np >> 5) & 1) + 32 * (np >> 6) + (np & 31);
}
__device__ __forceinline__ void transpose_tile(bool valid, int tl, const float* __restrict__ src, int src_ld, int k0, int n0_src,
                                               bf16_t* __restrict__ dst, int dst_ld, int n0_map, int mode, int off,
                                               float* T) {
  const int c4 = (tl & 15) * 4, r = tl >> 4;
  if (valid) {
    f32x4 v[8];
#pragma unroll
    for (int i = 0; i < 4; i++) {
      const float* sp = src + (size_t)(k0 + r + 16 * i) * src_ld + n0_src + c4;
      v[i] = __builtin_nontemporal_load((const f32x4*)sp); v[4 + i] = __builtin_nontemporal_load((const f32x4*)(sp + 64));
    }
    asm volatile("" :: "v"(v[0]), "v"(v[1]), "v"(v[2]), "v"(v[3]), "v"(v[4]), "v"(v[5]), "v"(v[6]), "v"(v[7]));
#pragma unroll
    for (int i = 0; i < 4; i++) {
      const int rr = r + 16 * i;
      T[rr * 65 + c4 + 0] = v[i][0]; T[rr * 65 + c4 + 1] = v[i][1]; T[rr * 65 + c4 + 2] = v[i][2]; T[rr * 65 + c4 + 3] = v[i][3];
      T[4160 + rr * 65 + c4 + 0] = v[4 + i][0]; T[4160 + rr * 65 + c4 + 1] = v[4 + i][1]; T[4160 + rr * 65 + c4 + 2] = v[4 + i][2]; T[4160 + rr * 65 + c4 + 3] = v[4 + i][3];
    }
  }
  __syncthreads();
  if (valid) {
    const int nn = tl >> 2, k16 = (tl & 3) * 16;
#pragma unroll
    for (int h2 = 0; h2 < 2; h2++) {
      const float* Th = T + h2 * 4160;
      const int drow = map_row(n0_map + 64 * h2 + nn, mode, off);
      unsigned w0 = pack2(Th[(k16 + 0) * 65 + nn], Th[(k16 + 1) * 65 + nn]);
      unsigned w1 = pack2(Th[(k16 + 2) * 65 + nn], Th[(k16 + 3) * 65 + nn]);
      unsigned w2 = pack2(Th[(k16 + 4) * 65 + nn], Th[(k16 + 5) * 65 + nn]);
      unsigned w3 = pack2(Th[(k16 + 6) * 65 + nn], Th[(k16 + 7) * 65 + nn]);
      unsigned w4 = pack2(Th[(k16 + 8) * 65 + nn], Th[(k16 + 9) * 65 + nn]);
      unsigned w5 = pack2(Th[(k16 + 10) * 65 + nn], Th[(k16 + 11) * 65 + nn]);
      unsigned w6 = pack2(Th[(k16 + 12) * 65 + nn], Th[(k16 + 13) * 65 + nn]);
      unsigned w7 = pack2(Th[(k16 + 14) * 65 + nn], Th[(k16 + 15) * 65 + nn]);
      uint4* d = (uint4*)(dst + (size_t)drow * dst_ld + k0 + k16);
      d[0] = make_uint4(w0, w1, w2, w3);
      d[1] = make_uint4(w4, w5, w6, w7);
    }
  }
  __syncthreads();
}

__device__ __forceinline__ void ada_item(const Params& p, bool valid, int tl, int it, float* sm) {
  const int layer = it / 96, cb = it % 96;
  const int w = tl >> 6, lane = tl & 63;
  if (valid) {
    for (int i = tl; i < 3072; i += 256) {
      int cnd = i >> 10, k = i & 1023;
      float v = (cnd == 0) ? p.c_ctx[k] : p.c[(cnd - 1) * 1024 + k];
      sm[i] = v / (1.f + expf(-v));
    }
  }
  __syncthreads();
  float* red = sm + 3072;
  if (valid) {
    const float* wp = p.ada_w + (size_t)layer * 1024 * NMOD + (size_t)(w * 256) * NMOD + cb * 64 + lane;
    float a0 = 0.f, a1 = 0.f, a2 = 0.f;
    for (int k0 = 0; k0 < 256; k0 += 16) {
      float wv[16];
#pragma unroll
      for (int j = 0; j < 16; j++) wv[j] = __builtin_nontemporal_load(wp + (size_t)(k0 + j) * NMOD);
      __builtin_amdgcn_sched_barrier(0);
#pragma unroll
      for (int j = 0; j < 16; j++) {
        const int kk = w * 256 + k0 + j;
        a0 += sm[kk] * wv[j]; a1 += sm[1024 + kk] * wv[j]; a2 += sm[2048 + kk] * wv[j];
      }
    }
    red[(w * 3 + 0) * 64 + lane] = a0;
    red[(w * 3 + 1) * 64 + lane] = a1;
    red[(w * 3 + 2) * 64 + lane] = a2;
  }
  __syncthreads();
  if (valid && tl < 192) {
    int cnd = tl >> 6, l = tl & 63;
    float s = red[(0 * 3 + cnd) * 64 + l] + red[(1 * 3 + cnd) * 64 + l] + red[(2 * 3 + cnd) * 64 + l] + red[(3 * 3 + cnd) * 64 + l];
    int n = cb * 64 + l;
    float* mod = (float*)(p.ws + WS_MOD);
    mod[(size_t)(layer * 3 + cnd) * NMOD + n] = s + p.ada_b[layer * NMOD + n];
  }
  __syncthreads();
}

__device__ __forceinline__ void sincos_d(double x, double& s, double& c) {
  const double n = rint(x * 0.15915494309189533576888);
  double r = fma(-n, 6.283185307179586, x);
  r = fma(-n, 2.4492935982947064e-16, r);
  const double r2 = r * r;
  double ss = 1.0, cc = 1.0;
#pragma unroll
  for (int k = 14; k >= 1; k--) {
    ss = 1.0 - ss * r2 * (1.0 / (double)((2 * k) * (2 * k + 1)));
    cc = 1.0 - cc * r2 * (1.0 / (double)((2 * k - 1) * (2 * k)));
  }
  s = r * ss; c = cc;
}


__device__ void prep_items(const Params& p, unsigned char* smem, int stage, int vb, int nvb, int part) {
  const int t = tid_opaque();
  const int hb = t >> 8, tl = t & 255;
  float* T = (float*)(smem + hb * HALF_LDS);
  const int jl = stage >> 1;
  const bool na = !(stage & 1);
  const int S_ADA = (stage == 0 && gridDim.x != 256) ? 384 : 0;
  const int S_MIX = S_ADA + (na ? 384 + 128 : 256);
  const int S_W1 = S_MIX + 352, S_W3 = S_W1 + 352, S_W2 = S_W3 + 352;
  const int S_CKV = S_W2 + (stage == 0 ? 2048 : 0);
  const int S_END = S_CKV + (stage == 0 ? 64 : 0);
  const int plo = (part == 1) ? (S_MIX >> 1) : 0;
  const int phi = (part == 1) ? (S_W2 >> 1) : (S_END >> 1);
  for (int pi = plo + vb; pi < phi; pi += nvb) {
    if (part == 0 && pi * 2 >= S_MIX && pi * 2 < S_W2) continue;
    const int it = pi * 2 + hb;
    const bool valid = it < S_END;
    if (pi * 2 < S_ADA) {
      ada_item(p, valid, tl, it, T);
    } else if (pi * 2 < S_MIX) {
      int r = it - S_ADA;
      if (na) {
        if (r < 384) {
          int kt = r / 24, nt = r % 24;
          transpose_tile(valid, tl, p.w_qkv + (size_t)jl * 1024 * 3072, 3072, kt * 64, nt * 128,
                         (bf16_t*)(p.ws + WS_WQKV) + (size_t)jl * 3072 * 1024, 1024, nt * 128, 2, 0, T);
        } else {
          r -= 384; int kt = r / 8, nt = r % 8;
          transpose_tile(valid, tl, p.w_o + (size_t)jl * 1024 * 1024, 1024, kt * 64, nt * 128,
                         (bf16_t*)(p.ws + WS_WO) + (size_t)jl * 1024 * 1024, 1024, nt * 128, 0, 0, T);
        }
      } else {
        int kt = r / 16, nt = r % 16;
        int n0 = nt * 128;
        int gate = n0 >= 1024;
        transpose_tile(valid, tl, p.w_glu + (size_t)jl * 1024 * 2048, 2048, kt * 64, n0,
                       (bf16_t*)(p.ws + WS_WGLU) + (size_t)jl * 2048 * 1024, 1024, gate ? n0 - 1024 : n0, 1, gate ? 16 : 0, T);
      }
    } else if (pi * 2 < S_W1) {
      int r = it - S_MIX; int kt = r / 22, nt = r % 22;
      transpose_tile(valid, tl, p.w1 + (size_t)stage * 1024 * DFF, DFF, kt * 64, nt * 128,
                     (bf16_t*)(p.ws + WS_W13) + (size_t)stage * 5632 * 1024, 1024, nt * 128, 1, 0, T);
    } else if (pi * 2 < S_W3) {
      int r = it - S_W1; int kt = r / 22, nt = r % 22;
      transpose_tile(valid, tl, p.w3 + (size_t)stage * 1024 * DFF, DFF, kt * 64, nt * 128,
                     (bf16_t*)(p.ws + WS_W13) + (size_t)stage * 5632 * 1024, 1024, nt * 128, 1, 16, T);
    } else if (pi * 2 < S_W2) {
      int r = it - S_W3; int kt = r / 8, nt = r % 8;
      transpose_tile(valid, tl, p.w2 + (size_t)stage * DFF * 1024, 1024, kt * 64, nt * 128,
                     (bf16_t*)(p.ws + WS_W2) + (size_t)stage * 1024 * DFF, DFF, nt * 128, 0, 0, T);
    } else if (pi * 2 < S_CKV) {
      int r = it - S_W2; const int isv = r >= 1024; r &= 1023;
      int bjh = r >> 4, sc = r & 15; int bj = bjh >> 4, h = bjh & 15;
      int s = sc * 32 + (tl >> 3), d8 = (tl & 7) * 8;
      const float* src = (isv ? p.cache_v : p.cache_k) + ((size_t)(bj * 512 + s) * 16 + h) * 64 + d8;
      const f32x4 v0 = __builtin_nontemporal_load((const f32x4*)src), v1 = __builtin_nontemporal_load((const f32x4*)(src + 4));
      bf16_t* dst = (bf16_t*)(p.ws + (isv ? WS_CV : WS_CK)) + ((size_t)bjh * 512 + s) * 64 + d8;
      *(uint4*)dst = make_uint4(pack2(v0[0], v0[1]), pack2(v0[2], v0[3]), pack2(v1[0], v1[1]), pack2(v1[2], v1[3]));
    } else if (valid) {
      const int idx = (it - S_CKV) * 256 + tl;
      const double lr = (double)p.lam_re[idx], li = (double)p.lam_im[idx];
      const double step = exp((double)p.log_step[idx >> 6]);
      const double mag = exp(lr * step);
      double sn, cs;
      sincos_d(li * step, sn, cs);
      const double are = mag * cs, aim = mag * sn;
      const double den = lr * lr + li * li;
      const double nr = are - 1.0, ni = aim;
      float4 o;
      o.x = (float)are; o.y = (float)aim;
      o.z = (float)((nr * lr + ni * li) / den);
      o.w = (float)((ni * lr - nr * li) / den);
      ((float4*)(p.ws + WS_DISC))[idx] = o;
    }
  }
}

__device__ void ada_stage(const Params& p, unsigned char* smem, int layer, int vb, int nvb) {
  const int t = tid_opaque();
  const int w = t >> 6, lane = t & 63;
  float* sm = (float*)smem;
  float* red = sm + 3072;
  for (int cb = vb; cb < 96; cb += nvb) {
    for (int i = t; i < 3072; i += 512) {
      int cnd = i >> 10, k = i & 1023;
      float v = (cnd == 0) ? p.c_ctx[k] : p.c[(cnd - 1) * 1024 + k];
      sm[i] = v / (1.f + expf(-v));
    }
    __syncthreads();
    const float* wp = p.ada_w + (size_t)layer * 1024 * NMOD + (size_t)(w * 128) * NMOD + cb * 64 + lane;
    float a0 = 0.f, a1 = 0.f, a2 = 0.f;
    for (int k0 = 0; k0 < 128; k0 += 16) {
      float wv[16];
#pragma unroll
      for (int j = 0; j < 16; j++) wv[j] = __builtin_nontemporal_load(wp + (size_t)(k0 + j) * NMOD);
      __builtin_amdgcn_sched_barrier(0);
#pragma unroll
      for (int j = 0; j < 16; j++) {
        const int kk = w * 128 + k0 + j;
        a0 += sm[kk] * wv[j]; a1 += sm[1024 + kk] * wv[j]; a2 += sm[2048 + kk] * wv[j];
      }
    }
    red[(w * 3 + 0) * 64 + lane] = a0;
    red[(w * 3 + 1) * 64 + lane] = a1;
    red[(w * 3 + 2) * 64 + lane] = a2;
    __syncthreads();
    if (t < 192) {
      const int cnd = t >> 6, l = t & 63;
      float s = 0.f;
#pragma unroll
      for (int ww = 0; ww < 8; ww++) s += red[(ww * 3 + cnd) * 64 + l];
      const int n = cb * 64 + l;
      float* mod = (float*)(p.ws + WS_MOD);
      mod[(size_t)(layer * 3 + cnd) * NMOD + n] = s + p.ada_b[layer * NMOD + n];
    }
    __syncthreads();
  }
}

__device__ void norm_phase(const float* __restrict__ xctx, const float* __restrict__ xlat,
                           const float* __restrict__ g, const float* __restrict__ modl, int chunk,
                           bf16_t* __restrict__ h, float* __restrict__ hf, float* __restrict__ xcopy) {
  const int t_ = tid_opaque(); const int lane = t_ & 63, w = t_ >> 6;
  const int rstep = gridDim.x * 8;
  int row = blockIdx.x * 8 + w;
  f32x4 nv0, nv1, nv2, nv3;
  {
    const float* xr = (row < NCTX) ? xctx + (size_t)row * DM : xlat + (size_t)(row - NCTX) * DM;
    nv0 = *(const f32x4*)(xr + lane * 4); nv1 = *(const f32x4*)(xr + lane * 4 + 256);
    nv2 = *(const f32x4*)(xr + lane * 4 + 512); nv3 = *(const f32x4*)(xr + lane * 4 + 768);
  }
  for (; row < NTOK; row += rstep) {
    f32x4 v[4] = {nv0, nv1, nv2, nv3};
    const int rn = row + rstep;
    if (rn < NTOK) {
      const float* xr = (rn < NCTX) ? xctx + (size_t)rn * DM : xlat + (size_t)(rn - NCTX) * DM;
      nv0 = *(const f32x4*)(xr + lane * 4); nv1 = *(const f32x4*)(xr + lane * 4 + 256);
      nv2 = *(const f32x4*)(xr + lane * 4 + 512); nv3 = *(const f32x4*)(xr + lane * 4 + 768);
    }
    float ss = 0.f;
#pragma unroll
    for (int i = 0; i < 4; i++) ss += v[i][0] * v[i][0] + v[i][1] * v[i][1] + v[i][2] * v[i][2] + v[i][3] * v[i][3];
#pragma unroll
    for (int o = 32; o >= 1; o >>= 1) ss += __shfl_xor(ss, o);
    const float rstd = 1.0f / sqrtf(ss * (1.f / 1024.f) + 1e-6f);
    const int cond = (row < NCTX) ? 0 : 1 + ((row - NCTX) >> 10);
    const float* sh = modl + (size_t)cond * NMOD + chunk * 1024;
    const float* sc = sh + 1024;
#pragma unroll
    for (int i = 0; i < 4; i++) {
      int col = lane * 4 + 256 * i;
      float4 gg = *(const float4*)(g + col);
      float4 s1 = *(const float4*)(sc + col);
      float4 s0 = *(const float4*)(sh + col);
      float y0 = v[i][0] * rstd * gg.x * (1.f + s1.x) + s0.x;
      float y1 = v[i][1] * rstd * gg.y * (1.f + s1.y) + s0.y;
      float y2 = v[i][2] * rstd * gg.z * (1.f + s1.z) + s0.z;
      float y3 = v[i][3] * rstd * gg.w * (1.f + s1.w) + s0.w;
      if (h) *(uint2*)(h + (size_t)row * DM + col) = make_uint2(pack2(y0, y1), pack2(y2, y3));
      if (hf) *(float4*)(hf + (size_t)row * DM + col) = make_float4(y0, y1, y2, y3);
      if (xcopy) *(f32x4*)(xcopy + (size_t)row * DM + col) = v[i];
    }
  }
}

namespace pg8 {
constexpr int BM = 256, BK = 64, HALF = 128, HTB = HALF * BK * 2, NXCD = 8, WGM = 8;
__device__ __forceinline__ int lds_byte(int r, int c) { const int st = (r >> 4) * 2 + (c >> 5), rr = r & 15, cc = c & 31, ob = rr * 64 + cc * 2; return st * 1024 + (ob ^ (((ob >> 9) & 1) << 5)); }
__device__ __forceinline__ void stage_rc(int b, int& R, int& C) { const int st = b / 1024, sb = b % 1024, swz = sb ^ (((sb >> 9) & 1) << 5); R = (st >> 1) * 16 + swz / 64; C = (st & 1) * 32 + (swz % 64) / 2; }
struct Unit { int pm, pn; };
struct Gemm { const bf16_t* A; const bf16_t* Bt; int M, N, K; };
struct StaticOrder {
  int nM, nN, nwg, G, c;
  __device__ void init(int M, int N, int G_, int c_) { nM = M / BM; nN = N / BM; nwg = nM * nN; G = G_; c = c_; }
  __device__ bool next(int i, Unit& u) const {
    const long L = (long)i * G + c; if (L >= nwg) return false;
    int wgid = (int)L; { const int q = nwg / NXCD, r = nwg % NXCD, xcd = wgid % NXCD, off = wgid / NXCD; wgid = (xcd < r ? xcd * (q + 1) : r * (q + 1) + (xcd - r) * q) + off; }
    const int nig = WGM * nN, gid = wgid / nig, fm = gid * WGM, gsz = (nM - fm) < WGM ? (nM - fm) : WGM;
    u.pm = fm + ((wgid % nig) % gsz); u.pn = (wgid % nig) / gsz; return true;
  }
};

template <class Epi>
__device__ __forceinline__ void gemm_phase(LAS unsigned char* lds, const Gemm g, const StaticOrder& S, const Epi& E) {
  const int tid = tid_opaque(), wid = __builtin_amdgcn_readfirstlane(tid >> 6), lane = tid & 63, wr = wid >> 2, wc = wid & 3, fr = lane & 15, fq = lane >> 4;
  const int K = g.K, nt = K / BK;
  unsigned voffA[2], voffB[2];
#pragma unroll
  for (int i = 0; i < 2; ++i) { int R, C; stage_rc(tid * 16 + i * 8192, R, C);
    voffA[i] = (unsigned)(R * K + C) * 2u; voffB[i] = voffA[i]; }
  const size_t kstep = (size_t)(BK * 2);
  const size_t hstep = (size_t)HALF * K * 2;
  const size_t tstep = 2 * hstep;
  const unsigned ldsw = (unsigned)wid * 1024u;
  const int aoff = lds_byte(wr * 64 + fr, fq * 8), boff = lds_byte(wc * 32 + fr, fq * 8);
#define PG8_SA(b, h) (((b) * 2 + (h)) * HTB)
#define PG8_SB(b, h) ((4 + (b) * 2 + (h)) * HTB)
#define PG8_STAGE(bufoff, gbase, voff) do { _Pragma("unroll") for (int _i = 0; _i < 2; ++_i) \
    __builtin_amdgcn_global_load_lds((const unsigned*)((const char*)(gbase) + (voff)[_i]), (LAS unsigned*)(lds + (bufoff) + ldsw + _i * 8192), 16, 0, 0); } while (0)
#define PG8_LDA(dst, b, h) do { _Pragma("unroll") for (int m = 0; m < 4; ++m) _Pragma("unroll") for (int k = 0; k < 2; ++k) dst[m][k] = *(const LAS bf16x8*)(lds + PG8_SA(b, h) + aoff + m * 2048 + k * 1024); } while (0)
#define PG8_LDB(dst, b, h) do { _Pragma("unroll") for (int n = 0; n < 2; ++n) _Pragma("unroll") for (int k = 0; k < 2; ++k) dst[n][k] = *(const LAS bf16x8*)(lds + PG8_SB(b, h) + boff + n * 2048 + k * 1024); } while (0)
#define PG8_MMA(ai, bj, At, Bt) do { __builtin_amdgcn_s_setprio(1); _Pragma("unroll") for (int m = 0; m < 4; ++m) _Pragma("unroll") for (int n = 0; n < 2; ++n) _Pragma("unroll") for (int k = 0; k < 2; ++k) \
    acc[ai][bj][m][n] = __builtin_amdgcn_mfma_f32_16x16x32_bf16(Bt[n][k], At[m][k], acc[ai][bj][m][n], 0, 0, 0); __builtin_amdgcn_s_setprio(0); } while (0)
#define PG8_WAIT_V(n) asm volatile("s_waitcnt vmcnt(" #n ")" ::: "memory")
#define PG8_WAIT_L(n) asm volatile("s_waitcnt lgkmcnt(" #n ")" ::: "memory")
#define PG8_BAR __builtin_amdgcn_s_barrier()
#define PG8_SCHED __builtin_amdgcn_sched_barrier(0)
  Unit cur, nxt; int ui = 0;
  if (!S.next(0, cur)) return;
  f32x4 acc[2][2][4][2];
#pragma unroll
  for (int a = 0; a < 2; ++a)
#pragma unroll
    for (int b = 0; b < 2; ++b)
#pragma unroll
      for (int m = 0; m < 4; ++m)
#pragma unroll
        for (int n = 0; n < 2; ++n) acc[a][b][m][n] = (f32x4){0.f, 0.f, 0.f, 0.f};
  bf16x8 At[4][2], B0[2][2], B1[2][2];
  const char* cA = (const char*)g.A + (size_t)cur.pm * tstep; const char* cB = (const char*)g.Bt + (size_t)cur.pn * tstep;
  PG8_STAGE(PG8_SB(0, 0), cB, voffB); PG8_STAGE(PG8_SA(0, 0), cA, voffA); PG8_STAGE(PG8_SB(0, 1), cB + hstep, voffB); PG8_STAGE(PG8_SA(0, 1), cA + hstep, voffA);
  if (wr == 1) PG8_BAR;
  PG8_WAIT_V(4); PG8_BAR;
  PG8_STAGE(PG8_SB(1, 0), cB + kstep, voffB); PG8_STAGE(PG8_SA(1, 0), cA + kstep, voffA); PG8_STAGE(PG8_SB(1, 1), cB + hstep + kstep, voffB);
  PG8_WAIT_V(6); PG8_BAR;
  for (;;) {
    const bool has_next = S.next(ui + 1, nxt);
    const char* nA = has_next ? (const char*)g.A + (size_t)nxt.pm * tstep : cA; const char* nB = has_next ? (const char*)g.Bt + (size_t)nxt.pn * tstep : cB;
    for (int t = 0; t < nt; t += 2) {
      const bool last = (t == nt - 2);
      const char* a1 = cA + (size_t)(t + 1) * kstep;
      const char* a2 = last ? nA : cA + (size_t)(t + 2) * kstep; const char* b2 = last ? nB : cB + (size_t)(t + 2) * kstep;
      const char* a3 = a2 + kstep; const char* b3 = b2 + kstep;
      PG8_LDB(B0, 0, 0); PG8_SCHED; PG8_LDA(At, 0, 0); PG8_STAGE(PG8_SA(1, 1), a1 + hstep, voffA);
      PG8_WAIT_L(8); PG8_BAR; PG8_WAIT_L(0); PG8_MMA(0, 0, At, B0); PG8_BAR; PG8_SCHED;
      PG8_LDB(B1, 0, 1); PG8_STAGE(PG8_SB(0, 0), b2, voffB);
      PG8_BAR; PG8_WAIT_L(0); PG8_MMA(0, 1, At, B1); PG8_BAR;
      PG8_LDA(At, 0, 1); PG8_STAGE(PG8_SA(0, 0), a2, voffA);
      PG8_BAR; PG8_WAIT_L(0); PG8_MMA(1, 0, At, B0); PG8_BAR; PG8_SCHED;
      PG8_STAGE(PG8_SB(0, 1), b2 + hstep, voffB);
      PG8_WAIT_V(6); PG8_BAR; PG8_MMA(1, 1, At, B1); PG8_BAR;
      PG8_LDB(B0, 1, 0); PG8_SCHED; PG8_LDA(At, 1, 0); PG8_STAGE(PG8_SA(0, 1), a2 + hstep, voffA);
      PG8_WAIT_L(8); PG8_BAR; PG8_WAIT_L(0); PG8_MMA(0, 0, At, B0); PG8_BAR; PG8_SCHED;
      PG8_LDB(B1, 1, 1); PG8_STAGE(PG8_SB(1, 0), b3, voffB);
      PG8_BAR; PG8_WAIT_L(0); PG8_MMA(0, 1, At, B1); PG8_BAR;
      PG8_LDA(At, 1, 1); PG8_STAGE(PG8_SA(1, 0), a3, voffA);
      PG8_BAR; PG8_WAIT_L(0); PG8_MMA(1, 0, At, B0); PG8_BAR; PG8_SCHED;
      PG8_STAGE(PG8_SB(1, 1), b3 + hstep, voffB);
      PG8_WAIT_V(6); PG8_BAR; PG8_MMA(1, 1, At, B1); PG8_BAR;
    }
    E(acc, cur, wr, wc, fr, fq);
    if (!has_next) break;
#pragma unroll
    for (int a = 0; a < 2; ++a)
#pragma unroll
      for (int b = 0; b < 2; ++b)
#pragma unroll
        for (int m = 0; m < 4; ++m)
#pragma unroll
          for (int n = 0; n < 2; ++n) acc[a][b][m][n] = (f32x4){0.f, 0.f, 0.f, 0.f};
    cur = nxt; cA = nA; cB = nB; ++ui;
  }
  PG8_WAIT_V(0);
  if (wr == 0) PG8_BAR;
  PG8_BAR;
#undef PG8_SA
#undef PG8_SB
#undef PG8_STAGE
#undef PG8_LDA
#undef PG8_LDB
#undef PG8_MMA
#undef PG8_WAIT_V
#undef PG8_WAIT_L
#undef PG8_BAR
#undef PG8_SCHED
}
}

typedef f32x4 AccT[2][2][4][2];
__device__ __forceinline__ int cond_of_pm(int pm) { return (pm < 32) ? 0 : 1 + ((pm - 32) >> 2); }

struct EpiResid {
  float* x; const float* gate; const float* rctx; const float* rlat;
  __device__ __forceinline__ void operator()(const AccT& acc, const pg8::Unit& u, int wr, int wc, int fr, int fq) const {
    const int row0 = u.pm * 256 + wr * 64 + fr, col0 = u.pn * 256 + wc * 32 + 4 * fq;
    const float* g = gate + (size_t)cond_of_pm(u.pm) * NMOD;
    f32x4 gv[2][2];
#pragma unroll
    for (int bj = 0; bj < 2; ++bj)
#pragma unroll
      for (int n = 0; n < 2; ++n) gv[bj][n] = *(const f32x4*)(g + col0 + bj * 128 + n * 16);
    const float* rbase = (u.pm < 32) ? rctx : rlat - (size_t)NCTX * DM;
#pragma unroll
    for (int ai = 0; ai < 2; ++ai) {
      f32x4 xv[4][2][2];
#pragma unroll
      for (int m = 0; m < 4; ++m)
#pragma unroll
        for (int bj = 0; bj < 2; ++bj)
#pragma unroll
          for (int n = 0; n < 2; ++n)
            xv[m][bj][n] = *(const f32x4*)(rbase + (size_t)(row0 + ai * 128 + m * 16) * DM + col0 + bj * 128 + n * 16);
#pragma unroll
      for (int m = 0; m < 4; ++m)
#pragma unroll
        for (int bj = 0; bj < 2; ++bj)
#pragma unroll
          for (int n = 0; n < 2; ++n)
            *(f32x4*)(x + (size_t)(row0 + ai * 128 + m * 16) * DM + col0 + bj * 128 + n * 16) = xv[m][bj][n] + gv[bj][n] * acc[ai][bj][m][n];
    }
  }
};
struct EpiSwiglu {
  bf16_t* u;
  __device__ __forceinline__ void operator()(const AccT& acc, const pg8::Unit& un, int wr, int wc, int fr, int fq) const {
    const int row0 = un.pm * 256 + wr * 64 + fr;
#pragma unroll
    for (int ai = 0; ai < 2; ++ai)
#pragma unroll
      for (int m = 0; m < 4; ++m) {
        bf16_t* rowp = u + (size_t)(row0 + ai * 128 + m * 16) * DFF;
#pragma unroll
        for (int bj = 0; bj < 2; ++bj) {
          const int col = 16 * (un.pn * 8 + bj * 4 + wc) + 4 * fq;
          const f32x4 a1 = acc[ai][bj][m][0], a3 = acc[ai][bj][m][1];
          u32x2 w;
          w.x = pack2(silu_f(a1[0]) * a3[0], silu_f(a1[1]) * a3[1]);
          w.y = pack2(silu_f(a1[2]) * a3[2], silu_f(a1[3]) * a3[3]);
          *(u32x2*)(rowp + col) = w;
        }
      }
  }
};
struct EpiGlu {
  float* x; const float* gate;
  __device__ __forceinline__ void operator()(const AccT& acc, const pg8::Unit& un, int wr, int wc, int fr, int fq) const {
    const int row0 = un.pm * 256 + wr * 64 + fr;
    const float* g = gate + (size_t)cond_of_pm(un.pm) * NMOD;
    f32x4 gv[2], xv[2][2][4];
#pragma unroll
    for (int bj = 0; bj < 2; ++bj) {
      const int col = 16 * (un.pn * 8 + bj * 4 + wc) + 4 * fq;
      gv[bj] = *(const f32x4*)(g + col);
#pragma unroll
      for (int ai = 0; ai < 2; ++ai)
#pragma unroll
        for (int m = 0; m < 4; ++m) xv[bj][ai][m] = *(const f32x4*)(x + (size_t)(row0 + ai * 128 + m * 16) * DM + col);
    }
#pragma unroll
    for (int bj = 0; bj < 2; ++bj) {
      const int col = 16 * (un.pn * 8 + bj * 4 + wc) + 4 * fq;
#pragma unroll
      for (int ai = 0; ai < 2; ++ai)
#pragma unroll
        for (int m = 0; m < 4; ++m) {
          const f32x4 val = acc[ai][bj][m][0], gt = acc[ai][bj][m][1];
          f32x4 o;
#pragma unroll
          for (int e = 0; e < 4; ++e) o[e] = val[e] * __builtin_amdgcn_rcpf(1.f + __expf(-gt[e]));
          *(f32x4*)(x + (size_t)(row0 + ai * 128 + m * 16) * DM + col) = xv[bj][ai][m] + gv[bj] * o;
        }
    }
  }
};
struct EpiQKV {
  const float* qg; const float* kg; bf16_t* q; bf16_t* k; bf16_t* v; float* nk; float* nv;
  __device__ __forceinline__ void operator()(const AccT& acc, const pg8::Unit& u, int wr, int wc, int fr, int fq) const {
    const int which = u.pn >> 2, hh = ((u.pn & 3) << 2) + wc;
    const int row0 = u.pm * 256 + wr * 64 + fr;
    const int cc0 = hh * 64 + 4 * fq;
    if (which < 2) {
      const float* gain = (which == 0) ? qg : kg;
      bf16_t* dstb = (which == 0) ? q : k;
      const float qscale = (which == 0) ? 0.125f * 1.4426950408889634f : 1.0f;
      f32x4 gn[2][2];
#pragma unroll
      for (int bj = 0; bj < 2; ++bj)
#pragma unroll
        for (int n = 0; n < 2; ++n) gn[bj][n] = *(const f32x4*)(gain + 32 * bj + 16 * n + 4 * fq);
#pragma unroll
      for (int ai = 0; ai < 2; ++ai)
#pragma unroll
        for (int m = 0; m < 4; ++m) {
          float ss = 0.f;
#pragma unroll
          for (int bj = 0; bj < 2; ++bj)
#pragma unroll
            for (int n = 0; n < 2; ++n) {
              const f32x4 a = acc[ai][bj][m][n];
              ss += a[0] * a[0] + a[1] * a[1] + a[2] * a[2] + a[3] * a[3];
            }
          ss += __shfl_xor(ss, 16); ss += __shfl_xor(ss, 32);
          const float rinv = 1.0f / sqrtf(ss * (1.f / 64.f) + 1e-6f);
          const int row = row0 + ai * 128 + m * 16;
#pragma unroll
          for (int bj = 0; bj < 2; ++bj)
#pragma unroll
            for (int n = 0; n < 2; ++n) {
              const f32x4 val = acc[ai][bj][m][n] * rinv * gn[bj][n];
              const int cc = cc0 + 32 * bj + 16 * n;
              const f32x4 vs = val * qscale;
              u32x2 w; w.x = pack2(vs[0], vs[1]); w.y = pack2(vs[2], vs[3]);
              *(u32x2*)(dstb + (size_t)row * DM + cc) = w;
              if (which == 1 && row < NCTX) {
                const int b = row >> 8, s = row & 255;
                __builtin_nontemporal_store(val, (f32x4*)(nk + ((size_t)b * 512 + s) * DM + cc));
              }
            }
        }
    } else {
#pragma unroll
      for (int ai = 0; ai < 2; ++ai)
#pragma unroll
        for (int m = 0; m < 4; ++m) {
          const int row = row0 + ai * 128 + m * 16;
#pragma unroll
          for (int bj = 0; bj < 2; ++bj)
#pragma unroll
            for (int n = 0; n < 2; ++n) {
              const f32x4 val = acc[ai][bj][m][n];
              const int cc = cc0 + 32 * bj + 16 * n;
              u32x2 w; w.x = pack2(val[0], val[1]); w.y = pack2(val[2], val[3]);
              *(u32x2*)(v + (size_t)row * DM + cc) = w;
              if (row < NCTX) {
                const int b = row >> 8, s = row & 255;
                __builtin_nontemporal_store(val, (f32x4*)(nv + ((size_t)b * 512 + s) * DM + cc));
              }
            }
        }
    }
  }
};

template <class Epi>
__device__ __forceinline__ void run_gemm(unsigned char* smem, const bf16_t* A, const bf16_t* Bt, int N, int K, const Epi& E) {
  pg8::Gemm g; g.A = A; g.Bt = Bt; g.M = NTOK; g.N = N; g.K = K;
  pg8::StaticOrder S; S.init(NTOK, N, (int)gridDim.x, (int)blockIdx.x);
  pg8::gemm_phase<Epi>((LAS unsigned char*)smem, g, S, E);
}

template <int NPAIR, bool LOCAL>
__device__ __forceinline__ void attn_chunk(const bf16_t* Ks, const bf16_t* Vs, const float* rpbs,
                                           const bf16x8 (&qf)[2], float& m, float& lsum, f32x4 (&oacc)[4],
                                           int l15, int q, int key_col0, int keyrow0_minus_r, int qc, int col_start) {
  constexpr int NT = 2 * NPAIR;
  f32x4 s[NT];
  float mx = -1e30f;
#pragma unroll
  for (int T = 0; T < NT; T++) {
    const int tstart = LOCAL ? ((T >> 1) * 64 + key_col0 + 16 * (T & 1)) : T * 16;
    f32x4 a4 = zero4();
#pragma unroll
    for (int ks = 0; ks < 2; ks++) {
      bf16x8 a = *(const bf16x8*)(Ks + (tstart + l15) * 72 + ks * 32 + q * 8);
      a4 = __builtin_amdgcn_mfma_f32_16x16x32_bf16(a, qf[ks], a4, 0, 0, 0);
    }
#pragma unroll
    for (int j = 0; j < 4; j++) {
      float v = a4[j];
      if (LOCAL) {
        const int kc = key_col0 + 16 * (T & 1) + 4 * q + j;
        const int dr = keyrow0_minus_r + (T >> 1);
        int dc = kc - qc; dc = dc < -15 ? -15 : (dc > 15 ? 15 : dc);
        const bool inwin = (kc >= col_start) && (kc < col_start + 16);
        v = inwin ? v + rpbs[(dr + 7) * 31 + dc + 15] : -1e30f;
      }
      a4[j] = v;
      mx = fmaxf(mx, v);
    }
    s[T] = a4;
  }
  mx = fmaxf(mx, __shfl_xor(mx, 16));
  mx = fmaxf(mx, __shfl_xor(mx, 32));
  const float mnew = fmaxf(m, mx);
  const float alpha = __builtin_amdgcn_exp2f(m - mnew);
  m = mnew;
  lsum *= alpha;
#pragma unroll
  for (int dt = 0; dt < 4; dt++)
#pragma unroll
    for (int j = 0; j < 4; j++) oacc[dt][j] *= alpha;
#pragma unroll
  for (int T = 0; T < NT; T++)
#pragma unroll
    for (int j = 0; j < 4; j++) {
      float pv = __builtin_amdgcn_exp2f(s[T][j] - mnew);
      lsum += pv;
      s[T][j] = pv;
    }
#pragma unroll
  for (int pp = 0; pp < NPAIR; pp++) {
    const int T0 = 2 * pp, T1 = 2 * pp + 1;
    const int ts0 = LOCAL ? (pp * 64 + key_col0) : T0 * 16;
    const int ts1 = ts0 + 16;
    union { bf16x8 v; unsigned u[4]; } pb;
    pb.u[0] = pack2(s[T0][0], s[T0][1]); pb.u[1] = pack2(s[T0][2], s[T0][3]);
    pb.u[2] = pack2(s[T1][0], s[T1][1]); pb.u[3] = pack2(s[T1][2], s[T1][3]);
    const bf16_t* vb0 = Vs + (ts0 + 4 * q + (l15 >> 2)) * 72 + 4 * (l15 & 3);
    const bf16_t* vb1 = Vs + (ts1 + 4 * q + (l15 >> 2)) * 72 + 4 * (l15 & 3);
#pragma unroll
    for (int dt = 0; dt < 4; dt++) {
      const s16x4 v0 = __builtin_amdgcn_ds_read_tr16_b64_v4i16((LAS s16x4*)(vb0 + dt * 16));
      const s16x4 v1 = __builtin_amdgcn_ds_read_tr16_b64_v4i16((LAS s16x4*)(vb1 + dt * 16));
      bf16x8 av;
      av[0] = v0[0]; av[1] = v0[1]; av[2] = v0[2]; av[3] = v0[3];
      av[4] = v1[0]; av[5] = v1[1]; av[6] = v1[2]; av[7] = v1[3];
      oacc[dt] = __builtin_amdgcn_mfma_f32_16x16x32_bf16(av, pb.v, oacc[dt], 0, 0, 0);
    }
  }
}

__device__ __forceinline__ void attn_src(bool lat, int b, int h, int jl, int row_start, int c,
                                         const bf16_t* Kb, const bf16_t* Vb, const bf16_t* CK, const bf16_t* CV,
                                         const bf16_t*& Ksrc, const bf16_t*& Vsrc, int& kstride) {
  if (!lat) {
    const size_t o = (size_t)(b * 256 + c * 128) * DM + h * 64;
    Ksrc = Kb + o; Vsrc = Vb + o; kstride = DM;
  } else if (c < 4) {
    const int kr0 = row_start + 2 * c;
    const size_t o = (size_t)(NCTX + b * 1024 + kr0 * 64) * DM + h * 64;
    Ksrc = Kb + o; Vsrc = Vb + o; kstride = DM;
  } else {
    const int cc = c - 4;
    const size_t o = ((size_t)((b * 2 + jl) * 16 + h) * 512 + cc * 128) * 64;
    Ksrc = CK + o; Vsrc = CV + o; kstride = 64;
  }
}

__device__ void attn_phase(const Params& p, int jl, unsigned char* smem) {
  const int t = tid_opaque();
  const int hb = t >> 8, tl = t & 255;
  bf16_t* Ks = (bf16_t*)(smem + hb * HALF_LDS);
  bf16_t* Vs = Ks + 128 * 72;
  float* rpbs = (float*)(Vs + 128 * 72);
  const bf16_t* Qb = (const bf16_t*)(p.ws + WS_Q);
  const bf16_t* Kb = (const bf16_t*)(p.ws + WS_K);
  const bf16_t* Vb = (const bf16_t*)(p.ws + WS_V);
  const bf16_t* CK = (const bf16_t*)(p.ws + WS_CK);
  const bf16_t* CV = (const bf16_t*)(p.ws + WS_CV);
  bf16_t* Ob = (bf16_t*)(p.ws + WS_O);
  const int lane = tl & 63, w = tl >> 6, l15 = lane & 15, q = lane >> 4;
  const int lkey = tl >> 3, ld8 = (tl & 7) * 8;
  for (int pi = blockIdx.x; pi < 1280; pi += gridDim.x) {
    const int it = pi * 2 + hb;
    const bool lat = pi < 256;
    int b, h, r = 0, token, row_start = 0, key_col0 = 0, qc = 0, col_start = 0;
    if (lat) {
      b = it >> 8; h = (it >> 4) & 15; r = it & 15;
      token = NCTX + b * 1024 + r * 64 + w * 16 + l15;
      row_start = r - 4; row_start = row_start < 0 ? 0 : (row_start > 8 ? 8 : row_start);
      key_col0 = 16 * w - 8; key_col0 = key_col0 < 0 ? 0 : (key_col0 > 32 ? 32 : key_col0);
      qc = 16 * w + l15;
      col_start = qc - 8; col_start = col_start < 0 ? 0 : (col_start > 48 ? 48 : col_start);
    } else {
      const int i2 = it - 512;
      b = i2 >> 6; h = (i2 >> 2) & 15; const int qb = i2 & 3;
      token = b * 256 + qb * 64 + w * 16 + l15;
    }
    const int nch = lat ? 8 : 2;
    u32x4 rk0, rk1, rk2, rk3, rv0, rv1, rv2, rv3;
    {
      const bf16_t* Ksrc; const bf16_t* Vsrc; int kstride;
      attn_src(lat, b, h, jl, row_start, 0, Kb, Vb, CK, CV, Ksrc, Vsrc, kstride);
      const bf16_t* kp = Ksrc + (size_t)lkey * kstride + ld8; const bf16_t* vp = Vsrc + (size_t)lkey * kstride + ld8;
      rk0 = *(const u32x4*)(kp); rk1 = *(const u32x4*)(kp + (size_t)32 * kstride); rk2 = *(const u32x4*)(kp + (size_t)64 * kstride); rk3 = *(const u32x4*)(kp + (size_t)96 * kstride);
      rv0 = *(const u32x4*)(vp); rv1 = *(const u32x4*)(vp + (size_t)32 * kstride); rv2 = *(const u32x4*)(vp + (size_t)64 * kstride); rv3 = *(const u32x4*)(vp + (size_t)96 * kstride);
    }
    bf16x8 qf[2];
    qf[0] = *(const bf16x8*)(Qb + (size_t)token * DM + h * 64 + q * 8);
    qf[1] = *(const bf16x8*)(Qb + (size_t)token * DM + h * 64 + 32 + q * 8);
    float m = -1e30f, lsum = 0.f;
    f32x4 oacc[4];
#pragma unroll
    for (int dt = 0; dt < 4; dt++) oacc[dt] = zero4();
    for (int c = 0; c < nch; c++) {
      __syncthreads();
      *(u32x4*)(Ks + (lkey + 0) * 72 + ld8) = rk0; *(u32x4*)(Ks + (lkey + 32) * 72 + ld8) = rk1;
      *(u32x4*)(Ks + (lkey + 64) * 72 + ld8) = rk2; *(u32x4*)(Ks + (lkey + 96) * 72 + ld8) = rk3;
      *(u32x4*)(Vs + (lkey + 0) * 72 + ld8) = rv0; *(u32x4*)(Vs + (lkey + 32) * 72 + ld8) = rv1;
      *(u32x4*)(Vs + (lkey + 64) * 72 + ld8) = rv2; *(u32x4*)(Vs + (lkey + 96) * 72 + ld8) = rv3;
      if (lat && c == 0) {
        for (int i = tl; i < 465; i += 256) rpbs[i] = p.rpb[(size_t)(jl * 16 + h) * 465 + i] * 1.4426950408889634f;
      }
      __syncthreads();
      if (c + 1 < nch) {
        const bf16_t* Ksrc; const bf16_t* Vsrc; int kstride;
        attn_src(lat, b, h, jl, row_start, c + 1, Kb, Vb, CK, CV, Ksrc, Vsrc, kstride);
        const bf16_t* kp = Ksrc + (size_t)lkey * kstride + ld8; const bf16_t* vp = Vsrc + (size_t)lkey * kstride + ld8;
        rk0 = *(const u32x4*)(kp); rk1 = *(const u32x4*)(kp + (size_t)32 * kstride); rk2 = *(const u32x4*)(kp + (size_t)64 * kstride); rk3 = *(const u32x4*)(kp + (size_t)96 * kstride);
        rv0 = *(const u32x4*)(vp); rv1 = *(const u32x4*)(vp + (size_t)32 * kstride); rv2 = *(const u32x4*)(vp + (size_t)64 * kstride); rv3 = *(const u32x4*)(vp + (size_t)96 * kstride);
      }
      if (lat && c < 4) {
        attn_chunk<2, true>(Ks, Vs, rpbs, qf, m, lsum, oacc, l15, q, key_col0, row_start + 2 * c - r, qc, col_start);
      } else {
        attn_chunk<4, false>(Ks, Vs, rpbs, qf, m, lsum, oacc, l15, q, 0, 0, 0, 0);
      }
    }
    lsum += __shfl_xor(lsum, 16);
    lsum += __shfl_xor(lsum, 32);
    const float inv = 1.f / lsum;
#pragma unroll
    for (int dt = 0; dt < 4; dt++) {
      uint2 pk = make_uint2(pack2(oacc[dt][0] * inv, oacc[dt][1] * inv), pack2(oacc[dt][2] * inv, oacc[dt][3] * inv));
      *(uint2*)(Ob + (size_t)token * DM + h * 64 + dt * 16 + q * 4) = pk;
    }
  }
}

#define WAVE_SYNC() do { asm volatile("s_waitcnt lgkmcnt(0)" ::: "memory"); __builtin_amdgcn_wave_barrier(); asm volatile("" ::: "memory"); } while (0)
__device__ __forceinline__ float bf_lo(float x, unsigned hi_bits16) { return x - __uint_as_float(hi_bits16 << 16); }

__device__ void s5_phase(const Params& p, int jl, unsigned char* smem) {
  const int t = tid_opaque();
  const int lane = t & 63, w = t >> 6, l15 = lane & 15, q = lane >> 4;
  float* BuS = (float*)(smem + w * 17408);
  unsigned* XsH = (unsigned*)(BuS + 16 * 132);
  unsigned* XsL = XsH + 16 * 68;
  const float* HF = (const float*)(p.ws + WS_HF);
  bf16_t* YF = (bf16_t*)(p.ws + WS_YF);
  bf16_t* YB = (bf16_t*)(p.ws + WS_YB);
  const float4* DISC = (const float4*)(p.ws + WS_DISC);
  const bool latw = (w == 0);
  int it = latw ? (int)blockIdx.x : (w - 1) * (int)gridDim.x + (int)blockIdx.x;
  int itstep = latw ? (int)gridDim.x : (int)gridDim.x * 7;
  int itend = latw ? 256 : 4096;
  if (gridDim.x == 256 && !latw) {
    const int start = (w < 4) ? (w - 1) * 3 : (w == 4 ? 15 : 9 + (w - 5) * 2);
    const int cnt = (w < 4) ? 3 : (w == 4 ? 1 : 2);
    it = (int)blockIdx.x * 16 + start; itstep = 1; itend = it + cnt;
  }
  for (; it < itend; it += itstep) {
    const bool lat = latw;
    const int bt = lat ? 32 + (it >> 7) : (it >> 7);
    const int rest = it & 127;
    const int dir = rest >> 6, g = rest & 63;
    const int L = lat ? 1024 : 256;
    const int tokbase = lat ? NCTX + (bt - 32) * 1024 : bt * 256;
    const int pg = (jl * 2 + dir) * 64 + g;
    bf16x8 Bh[8];
    {
      const int c0 = 8 * (q & 1);
#pragma unroll
      for (int nn = 0; nn < 4; nn++) {
        const int ps = 16 * nn + l15;
        const float4 dd = DISC[pg * 64 + ps];
        const float fre = dd.z, fim = dd.w;
        const float4 br0 = *(const float4*)(p.b_re + (size_t)(pg * 64 + ps) * 16 + c0);
        const float4 br1 = *(const float4*)(p.b_re + (size_t)(pg * 64 + ps) * 16 + c0 + 4);
        const float4 bi0 = *(const float4*)(p.b_im + (size_t)(pg * 64 + ps) * 16 + c0);
        const float4 bi1 = *(const float4*)(p.b_im + (size_t)(pg * 64 + ps) * 16 + c0 + 4);
        float vr[8], vi[8];
        vr[0] = fre * br0.x - fim * bi0.x; vi[0] = fre * bi0.x + fim * br0.x;
        vr[1] = fre * br0.y - fim * bi0.y; vi[1] = fre * bi0.y + fim * br0.y;
        vr[2] = fre * br0.z - fim * bi0.z; vi[2] = fre * bi0.z + fim * br0.z;
        vr[3] = fre * br0.w - fim * bi0.w; vi[3] = fre * bi0.w + fim * br0.w;
        vr[4] = fre * br1.x - fim * bi1.x; vi[4] = fre * bi1.x + fim * br1.x;
        vr[5] = fre * br1.y - fim * bi1.y; vi[5] = fre * bi1.y + fim * br1.y;
        vr[6] = fre * br1.z - fim * bi1.z; vi[6] = fre * bi1.z + fim * br1.z;
        vr[7] = fre * br1.w - fim * bi1.w; vi[7] = fre * bi1.w + fim * br1.w;
        union { bf16x8 v; unsigned u[4]; } hr, hi;
#pragma unroll
        for (int e = 0; e < 4; e++) {
          hr.u[e] = pack2(vr[2 * e], vr[2 * e + 1]);
          hi.u[e] = pack2(vi[2 * e], vi[2 * e + 1]);
        }
        Bh[nn] = hr.v; Bh[4 + nn] = hi.v;
      }
    }
    bf16x8 Ch[4];
    {
      const float* cr = p.c_re + ((size_t)pg * 16 + l15) * 64 + 4 * q;
      const float* ci = p.c_im + ((size_t)pg * 16 + l15) * 64 + 4 * q;
#pragma unroll
      for (int kk = 0; kk < 4; kk++) {
        const float4 a = *(const float4*)(cr + 16 * kk);
        const float4 b = *(const float4*)(ci + 16 * kk);
        float v[8] = {a.x, -b.x, a.y, -b.y, a.z, -b.z, a.w, -b.w};
        union { bf16x8 v; unsigned u[4]; } h;
#pragma unroll
        for (int e = 0; e < 4; e++) h.u[e] = pack2(v[2 * e], v[2 * e + 1]);
        Ch[kk] = h.v;
      }
    }
    const float4 dme = DISC[pg * 64 + lane];
    const float a_re = dme.x, a_im = dme.y;
    float xr = 0.f, xi = 0.f;
    if (lat) {
      const size_t sidx = ((size_t)(((bt - 32) * 2 + jl) * 2 + dir) * 64 + g) * 64 + lane;
      xr = p.st_re[sidx]; xi = p.st_im[sidx];
    }
    const int nch = L >> 4;
    const float* ubase = HF + (size_t)(tokbase + l15) * DM + g * 16 + 8 * (q & 1);
    bf16_t* ybase = (dir ? YB : YF) + (size_t)(tokbase + l15) * DM + g * 16 + 4 * q;
    const float* usk = HF + (size_t)(tokbase + l15) * DM + g * 16 + 4 * q;
    float4 dsk4 = *(const float4*)(p.ssm_d + (size_t)jl * DM + g * 16 + 4 * q);
    if (dir) dsk4 = make_float4(0.f, 0.f, 0.f, 0.f);
    const int t00 = dir ? L - 16 : 0;
    const int tstep = dir ? -16 : 16;
    float4 ra0 = *(const float4*)(ubase + (size_t)t00 * DM),               ra1 = *(const float4*)(ubase + (size_t)t00 * DM + 4);
    float4 rb0 = *(const float4*)(ubase + (size_t)(t00 + tstep) * DM),     rb1 = *(const float4*)(ubase + (size_t)(t00 + tstep) * DM + 4);
    float4 rc0 = *(const float4*)(ubase + (size_t)(t00 + 2 * tstep) * DM), rc1 = *(const float4*)(ubase + (size_t)(t00 + 2 * tstep) * DM + 4);
    for (int ci = 0; ci < nch; ci++) {
      const int t0 = dir ? L - 16 * (ci + 1) : 16 * ci;
      const float4 u0 = ra0, u1 = ra1;
      const float4 usk4 = *(const float4*)(usk + (size_t)t0 * DM);
      ra0 = rb0; ra1 = rb1; rb0 = rc0; rb1 = rc1;
      if (ci + 3 < nch) {
        const int t0n = t0 + 3 * tstep;
        rc0 = *(const float4*)(ubase + (size_t)t0n * DM);
        rc1 = *(const float4*)(ubase + (size_t)t0n * DM + 4);
      }
      union { bf16x8 v; unsigned u[4]; } uh, ul;
      uh.u[0] = pack2(u0.x, u0.y); uh.u[1] = pack2(u0.z, u0.w); uh.u[2] = pack2(u1.x, u1.y); uh.u[3] = pack2(u1.z, u1.w);
      ul.u[0] = pack2(bf_lo(u0.x, uh.u[0] & 0xffffu), bf_lo(u0.y, uh.u[0] >> 16));
      ul.u[1] = pack2(bf_lo(u0.z, uh.u[1] & 0xffffu), bf_lo(u0.w, uh.u[1] >> 16));
      ul.u[2] = pack2(bf_lo(u1.x, uh.u[2] & 0xffffu), bf_lo(u1.y, uh.u[2] >> 16));
      ul.u[3] = pack2(bf_lo(u1.z, uh.u[3] & 0xffffu), bf_lo(u1.w, uh.u[3] >> 16));
      const bf16x8 uf = (q < 2) ? uh.v : ul.v;
      f32x4 d[8];
#pragma unroll
      for (int n = 0; n < 8; n++) d[n] = __builtin_amdgcn_mfma_f32_16x16x32_bf16(Bh[n], uf, zero4(), 0, 0, 0);
      WAVE_SYNC();
#pragma unroll
      for (int n = 0; n < 8; n++) *(f32x4*)(BuS + l15 * 132 + 16 * n + 4 * q) = d[n];
      WAVE_SYNC();
      float bur[16], bui[16];
#pragma unroll
      for (int s = 0; s < 16; s++) {
        const int rr = dir ? 15 - s : s;
        bur[s] = BuS[rr * 132 + lane];
        bui[s] = BuS[rr * 132 + 64 + lane];
      }
      __builtin_amdgcn_sched_barrier(0);
#pragma unroll
      for (int s = 0; s < 16; s++) {
        const int rr = dir ? 15 - s : s;
        const float nxr = a_re * xr - a_im * xi + bur[s];
        const float nxi = a_re * xi + a_im * xr + bui[s];
        xr = nxr; xi = nxi;
        XsH[rr * 68 + lane] = pack2(xr, xi);
      }
      WAVE_SYNC();
      f32x4 acc0 = zero4(), acc1 = zero4();
#pragma unroll
      for (int kk = 0; kk < 4; kk++) {
        const bf16x8 xh = *(const bf16x8*)(XsH + l15 * 68 + 16 * kk + 4 * q);
        if (kk & 1) acc1 = __builtin_amdgcn_mfma_f32_16x16x32_bf16(Ch[kk], xh, acc1, 0, 0, 0);
        else        acc0 = __builtin_amdgcn_mfma_f32_16x16x32_bf16(Ch[kk], xh, acc0, 0, 0, 0);
      }
      const f32x4 acc2 = zero4();
      {
        const f32x4 yv = acc0 + (acc1 + acc2);
        u32x2 yw;
        yw.x = pack2(yv[0] + dsk4.x * usk4.x, yv[1] + dsk4.y * usk4.y);
        yw.y = pack2(yv[2] + dsk4.z * usk4.z, yv[3] + dsk4.w * usk4.w);
        *(u32x2*)(ybase + (size_t)t0 * DM) = yw;
      }
    }
    if (!lat) {
      const size_t oidx = ((size_t)((bt * 2 + jl) * 2 + dir) * 64 + g) * 64 + lane;
      p.out[OUT_SRE + oidx] = xr;
      p.out[OUT_SIM + oidx] = xi;
    }
  }
}

__device__ void combine_phase(const Params& p, int jl) {
  const u32x2* YF = (const u32x2*)(p.ws + WS_YF);
  const u32x2* YB = (const u32x2*)(p.ws + WS_YB);
  u32x2* Z = (u32x2*)(p.ws + WS_H);
  const size_t n4 = (size_t)NTOK * DM / 4;
  const int t_ = tid_opaque();
  for (size_t i = (size_t)blockIdx.x * 512 + t_; i < n4; i += (size_t)gridDim.x * 512) {
    const u32x2 a = YF[i], b = YB[i];
    const float y0 = __uint_as_float(a.x << 16) + __uint_as_float(b.x << 16);
    const float y1 = __uint_as_float(a.x & 0xffff0000u) + __uint_as_float(b.x & 0xffff0000u);
    const float y2 = __uint_as_float(a.y << 16) + __uint_as_float(b.y << 16);
    const float y3 = __uint_as_float(a.y & 0xffff0000u) + __uint_as_float(b.y & 0xffff0000u);
    u32x2 z; z.x = pack2(gelu_tanh(y0), gelu_tanh(y1)); z.y = pack2(gelu_tanh(y2), gelu_tanh(y3));
    Z[i] = z;
  }
}

#define XB_TMO      128
#define XB_XCNT(j)  (256  + 64 * (j))
#define XB_XSUB(j)  (1280 + 64 * (j))
#define XB_XGEN(j)  (2304 + 64 * (j))
#define XB_TOP      3328
#define XB_TOPGEN   3392
#define XCD_BAR_WORDS 3456
#define XB_SPIN_CAP (1u << 22)

__device__ __forceinline__ unsigned xb_ld(unsigned* p)              { return __hip_atomic_load(p, __ATOMIC_RELAXED, __HIP_MEMORY_SCOPE_AGENT); }
__device__ __forceinline__ unsigned xb_add(unsigned* p, unsigned v) { return __hip_atomic_fetch_add(p, v, __ATOMIC_RELAXED, __HIP_MEMORY_SCOPE_AGENT); }
__device__ __forceinline__ unsigned xb_xcc_id() { return (unsigned)__builtin_amdgcn_s_getreg((3 << 11) | 20) & 0xFu; }
#define XB_SPIN(cond, bar) do { unsigned _sp = 0; while (cond) { __builtin_amdgcn_s_sleep(1); \
    if ((++_sp & 255u) == 0u) { if (xb_ld(&(bar)[XB_TMO])) break; if (_sp > XB_SPIN_CAP) { atomicAdd(&(bar)[XB_TMO], 1u); break; } } } } while (0)

struct XcdBarrier { unsigned* bar; unsigned x; volatile LAS unsigned* st; };

__device__ __forceinline__ XcdBarrier xcd_barrier_post(unsigned* bar, volatile LAS unsigned* st) {
  XcdBarrier b; b.bar = bar; b.x = xb_xcc_id(); b.st = st;
  if (threadIdx.x == 0) (void)xb_add(&bar[XB_XCNT(b.x)], 1u);
  return b;
}
__device__ __forceinline__ void xcd_barrier_complete(unsigned* bar, unsigned x, unsigned& nloc, unsigned& nx) {
  const unsigned G = gridDim.x * gridDim.y * gridDim.z;
  unsigned sum, cnt, mine, sp = 0u;
  for (;;) {
    sum = 0u; cnt = 0u; mine = 0u;
#pragma unroll
    for (unsigned j = 0; j < 16; ++j) { const unsigned c = xb_ld(&bar[XB_XCNT(j)]); sum += c; cnt += (c > 0u) ? 1u : 0u; mine = (j == x) ? c : mine; }
    if (sum == G) break;
    __builtin_amdgcn_s_sleep(1);
    if ((++sp & 255u) == 0u) { if (xb_ld(&bar[XB_TMO])) break; if (sp > XB_SPIN_CAP) { atomicAdd(&bar[XB_TMO], 1u); break; } }
  }
  nloc = mine > 0u ? mine : 1u; nx = cnt > 0u ? cnt : 1u;
}
__device__ __forceinline__ void xcd_barrier(unsigned* bar_, volatile LAS unsigned* st_) {
  XcdBarrier b; b.bar = bar_; b.x = xb_xcc_id(); b.st = st_;
  asm volatile("s_waitcnt vmcnt(0)" ::: "memory");
  __syncthreads();
  if (threadIdx.x == 0) {
    unsigned* bar = b.bar;
    __builtin_amdgcn_s_waitcnt(0);
    unsigned nloc = b.st[0], nx = b.st[1];
    if (nloc == 0u) { xcd_barrier_complete(bar, b.x, nloc, nx); b.st[0] = nloc; b.st[1] = nx; }
    const unsigned old = xb_add(&bar[XB_XSUB(b.x)], 1u);
    const unsigned gen = old / nloc;
    if (old + 1u == (gen + 1u) * nloc) {
      __builtin_amdgcn_fence(__ATOMIC_RELEASE, "agent");
      asm volatile("s_waitcnt vmcnt(0)" ::: "memory");
      const unsigned og = xb_add(&bar[XB_TOP], 1u);
      const unsigned tg = og / nx;
      if (og + 1u == (tg + 1u) * nx) xb_add(&bar[XB_TOPGEN], 1u);
      else XB_SPIN(xb_ld(&bar[XB_TOPGEN]) == tg, bar);
      __builtin_amdgcn_fence(__ATOMIC_ACQUIRE, "agent");
      xb_add(&bar[XB_XGEN(b.x)], 1u);
      asm volatile("s_waitcnt vmcnt(0)" ::: "memory");
    } else {
      XB_SPIN(xb_ld(&bar[XB_XGEN(b.x)]) == gen, bar);
      __builtin_amdgcn_fence(__ATOMIC_ACQUIRE, "agent");
      asm volatile("s_waitcnt vmcnt(0)" ::: "memory");
    }
  }
  __syncthreads();
}

__global__ void __launch_bounds__(512, 2) mega_kernel(Params p) {
  extern __shared__ __attribute__((aligned(16))) unsigned char smem[];
  cg::grid_group grid = cg::this_grid();
  if (threadIdx.x == 0) *(uint4*)(smem + SMEM_BAR) = make_uint4(0u, 0u, 0u, 0u);
  __syncthreads();
  (void)xcd_barrier_post((unsigned*)(p.ws + WS_BAR), (volatile LAS unsigned*)(smem + SMEM_BAR));
#define GSYNC() xcd_barrier((unsigned*)(p.ws + WS_BAR), (volatile LAS unsigned*)(smem + SMEM_BAR))
  if (p.ws == nullptr) grid.sync();
  const float* mod = (const float*)(p.ws + WS_MOD);
  bf16_t* H = (bf16_t*)(p.ws + WS_H);
  float* X = p.out + OUT_X;

  if ((int)gridDim.x == 256) {
    if ((int)blockIdx.x < 96) ada_stage(p, smem, 0, (int)blockIdx.x, 96);
    else prep_items(p, smem, 0, (int)blockIdx.x - 96, 160, 0);
  } else {
    prep_items(p, smem, 0, (int)blockIdx.x, (int)gridDim.x, 2);
  }
  GSYNC();

#pragma unroll 1
  for (int i = 0; i < 4; i++) {
    const int jl = i >> 1;
    const bool ssm = (i & 1);
    const float* modl = mod + (size_t)i * 3 * NMOD;
    if (i == 0)
      norm_phase(p.x_prompt, p.x_sample, p.norm_mix + i * DM, modl, 0, H, nullptr, nullptr);
    else
      norm_phase(X, X + (size_t)NCTX * DM, p.norm_mix + i * DM, modl, 0, ssm ? nullptr : H, ssm ? (float*)(p.ws + WS_HF) : nullptr, nullptr);
    GSYNC();
    if (!ssm) {
      EpiQKV eq;
      eq.qg = p.q_gain + jl * 64; eq.kg = p.k_gain + jl * 64;
      eq.q = (bf16_t*)(p.ws + WS_Q); eq.k = (bf16_t*)(p.ws + WS_K); eq.v = (bf16_t*)(p.ws + WS_V);
      eq.nk = p.out + OUT_NK + (size_t)jl * 256 * DM; eq.nv = p.out + OUT_NV + (size_t)jl * 256 * DM;
      run_gemm(smem, H, (const bf16_t*)(p.ws + WS_WQKV) + (size_t)jl * 3072 * 1024, 3072, 1024, eq);
      GSYNC();
      attn_phase(p, jl, smem);
      GSYNC();
      EpiResid er; er.x = X; er.gate = modl + 2 * 1024;
      er.rctx = (i == 0) ? p.x_prompt : X; er.rlat = (i == 0) ? p.x_sample : X + (size_t)NCTX * DM;
      run_gemm(smem, (const bf16_t*)(p.ws + WS_O), (const bf16_t*)(p.ws + WS_WO) + (size_t)jl * 1024 * 1024, 1024, 1024, er);
      if (i == 0 && (int)blockIdx.x >= 160 && (int)gridDim.x == 256)
        prep_items(p, smem, 0, (int)blockIdx.x - 160, (int)gridDim.x - 160, 1);
      GSYNC();
    } else {
      s5_phase(p, jl, smem);
      GSYNC();
      combine_phase(p, jl);
      GSYNC();
      EpiGlu eg; eg.x = X; eg.gate = modl + 2 * 1024;
      run_gemm(smem, H, (const bf16_t*)(p.ws + WS_WGLU) + (size_t)jl * 2048 * 1024, 2048, 1024, eg);
      GSYNC();
    }
    norm_phase(X, X + (size_t)NCTX * DM, p.norm_ffn + i * DM, modl, 3, H, nullptr, nullptr);
    GSYNC();
    EpiSwiglu es; es.u = (bf16_t*)(p.ws + WS_U);
    run_gemm(smem, H, (const bf16_t*)(p.ws + WS_W13) + (size_t)i * 5632 * 1024, 5632, 1024, es);
    if (i < 3 && (int)gridDim.x == 256 && (int)blockIdx.x >= 112)
      ada_stage(p, smem, i + 1, (int)blockIdx.x - 112, 144);
    GSYNC();
    EpiResid ed; ed.x = X; ed.gate = modl + 5 * 1024; ed.rctx = X; ed.rlat = X + (size_t)NCTX * DM;
    run_gemm(smem, (const bf16_t*)(p.ws + WS_U), (const bf16_t*)(p.ws + WS_W2) + (size_t)i * 1024 * DFF, 1024, DFF, ed);
    if (i < 3 && (int)blockIdx.x >= 160 && (int)gridDim.x > 160)
      prep_items(p, smem, i + 1, (int)blockIdx.x - 160, (int)gridDim.x - 160, 2);
    GSYNC();
  }
}

extern "C" void kernel_launch(void* const* d_in, const int* in_sizes, int n_in, void* d_out, int out_size,
                              void* d_ws, size_t ws_size, hipStream_t stream) {
  static int grid_blocks = 0;
  if (!grid_blocks) {
    int dev = 0, cus = 0, per_cu = 0;
    (void)hipGetDevice(&dev);
    (void)hipDeviceGetAttribute(&cus, hipDeviceAttributeMultiprocessorCount, dev);
    (void)hipFuncSetAttribute((const void*)mega_kernel, hipFuncAttributeMaxDynamicSharedMemorySize, SMEM_BYTES);
    (void)hipOccupancyMaxActiveBlocksPerMultiprocessor(&per_cu, mega_kernel, 512, SMEM_BYTES);
    if (per_cu > 1) per_cu = 1;
    if (per_cu < 1) per_cu = 1;
    grid_blocks = cus * per_cu;
  }
  if (ws_size < WS_END) { fprintf(stderr, "workspace too small: %zu < %zu\n", ws_size, (size_t)WS_END); return; }
  Params p{};
  const float** pp = (const float**)&p;
  for (int i = 0; i < 29; i++) pp[i] = (const float*)d_in[i];
  p.out = (float*)d_out;
  p.ws = (unsigned char*)d_ws;
  (void)hipMemsetAsync((unsigned char*)d_ws + WS_BAR, 0, XCD_BAR_WORDS * 4, stream);
  void* args[] = {&p};
  hipError_t err = hipLaunchCooperativeKernel((void*)mega_kernel, dim3(grid_blocks), dim3(512), args, SMEM_BYTES, stream);
  if (err != hipSuccess) fprintf(stderr, "cooperative launch failed: %s (grid %d)\n", hipGetErrorString(err), grid_blocks);
}
```

```cpp
#include <hip/hip_runtime.h>
#include <hip/hip_cooperative_groups.h>
#include <cstdio>
#include <cstdint>
namespace cg = cooperative_groups;

typedef unsigned short bf16_t;
typedef __attribute__((ext_vector_type(8))) short bf16x8;
typedef __attribute__((ext_vector_type(4))) short s16x4;
typedef __attribute__((ext_vector_type(4))) float f32x4;
typedef __attribute__((ext_vector_type(4))) unsigned u32x4;
typedef __attribute__((ext_vector_type(2))) unsigned u32x2;
#define LAS __attribute__((address_space(3)))

constexpr int DM = 1024;
constexpr int NCTX = 8192;
constexpr int NLAT = 2048;
constexpr int NTOK = 10240;
constexpr int DFF = 2816;
constexpr int NMOD = 6144;

constexpr size_t OUT_X   = 0;
constexpr size_t OUT_NK  = 10485760;
constexpr size_t OUT_NV  = 27262976;
constexpr size_t OUT_SRE = 44040192;
constexpr size_t OUT_SIM = 44564480;

constexpr size_t WS_WQKV = 0;
constexpr size_t WS_WO   = WS_WQKV + 12582912;
constexpr size_t WS_WGLU = WS_WO   + 4194304;
constexpr size_t WS_W13  = WS_WGLU + 8388608;
constexpr size_t WS_W2   = WS_W13  + 46137344;
constexpr size_t WS_MOD  = WS_W2   + 23068672;
constexpr size_t WS_CK   = WS_MOD  + 294912;
constexpr size_t WS_CV   = WS_CK   + 4194304;
constexpr size_t WS_H    = WS_CV   + 4194304;
constexpr size_t WS_R    = WS_H    + 20971520;
constexpr size_t WS_Q    = WS_R;
constexpr size_t WS_K    = WS_Q + 20971520;
constexpr size_t WS_V    = WS_K + 20971520;
constexpr size_t WS_O    = WS_V + 20971520;
constexpr size_t WS_U    = WS_R;
constexpr size_t WS_HF   = WS_R;
constexpr size_t WS_YF   = WS_HF + 41943040;
constexpr size_t WS_YB   = WS_YF + 41943040;
constexpr size_t WS_BAR  = WS_R + 125829120;
constexpr size_t WS_DISC = WS_BAR + 16384;
constexpr size_t WS_END  = WS_DISC + 262144;

constexpr int SMEM_STAGE = 131072;
constexpr int SMEM_BYTES = 147456 + 64;
constexpr int SMEM_BAR = 147456;
constexpr int HALF_LDS = 40960;

struct Params {
  const float *x_prompt, *x_sample, *cache_k, *cache_v, *st_re, *st_im, *c, *c_ctx;
  const float *norm_mix, *norm_ffn, *ada_w, *ada_b, *w_qkv, *w_o, *q_gain, *k_gain, *rpb;
  const float *lam_re, *lam_im, *log_step, *b_re, *b_im, *c_re, *c_im, *ssm_d, *w_glu, *w1, *w3, *w2;
  float* out;
  unsigned char* ws;
};

__device__ __forceinline__ unsigned f2bf(float f) {
  unsigned u = __float_as_uint(f);
  u += 0x7fffu + ((u >> 16) & 1u);
  return u >> 16;
}
typedef __bf16 bf16n2 __attribute__((ext_vector_type(2)));
typedef float f32x2 __attribute__((ext_vector_type(2)));
__device__ __forceinline__ unsigned pack2(float a, float b) { f32x2 v = {a, b}; bf16n2 r = __builtin_convertvector(v, bf16n2); return __builtin_bit_cast(unsigned, r); }
__device__ __forceinline__ float silu_f(float x) { return x * __builtin_amdgcn_rcpf(1.f + __expf(-x)); }
__device__ __forceinline__ float gelu_tanh(float y) {
  float a = 1.5957691216057308f * (y + 0.044715f * y * y * y);
  return y * __builtin_amdgcn_rcpf(1.f + __expf(-a));
}
__device__ __forceinline__ int tid_opaque() { int t = threadIdx.x; asm volatile("" : "+v"(t)); return t; }
__device__ __forceinline__ f32x4 zero4() { f32x4 z = {0.f, 0.f, 0.f, 0.f}; return z; }

__device__ __forceinline__ int map_row(int n, int mode, int off) {
  if (mode == 0) return n;
  if (mode == 1) return (n >> 4) * 32 + off + (n & 15);
  const int np = n & 255;
  return (n & ~255) + 128 * ((np >> 5) & 1) + 32 * (np >> 6) + (np & 31);
}
__device__ __forceinline__ void transpose_tile(bool valid, int tl, const float* __restrict__ src, int src_ld, int k0, int n0_src,
                                               bf16_t* __restrict__ dst, int dst_ld, int n0_map, int mode, int off,
                                               float* T) {
  const int c4 = (tl & 15) * 4, r = tl >> 4;
  if (valid) {
    f32x4 v[8];
#pragma unroll
    for (int i = 0; i < 4; i++) {
      const float* sp = src + (size_t)(k0 + r + 16 * i) * src_ld + n0_src + c4;
      v[i] = __builtin_nontemporal_load((const f32x4*)sp); v[4 + i] = __builtin_nontemporal_load((const f32x4*)(sp + 64));
    }
    asm volatile("" :: "v"(v[0]), "v"(v[1]), "v"(v[2]), "v"(v[3]), "v"(v[4]), "v"(v[5]), "v"(v[6]), "v"(v[7]));
#pragma unroll
    for (int i = 0; i < 4; i++) {
      const int rr = r + 16 * i;
      T[rr * 65 + c4 + 0] = v[i][0]; T[rr * 65 + c4 + 1] = v[i][1]; T[rr * 65 + c4 + 2] = v[i][2]; T[rr * 65 + c4 + 3] = v[i][3];
      T[4160 + rr * 65 + c4 + 0] = v[4 + i][0]; T[4160 + rr * 65 + c4 + 1] = v[4 + i][1]; T[4160 + rr * 65 + c4 + 2] = v[4 + i][2]; T[4160 + rr * 65 + c4 + 3] = v[4 + i][3];
    }
  }
  __syncthreads();
  if (valid) {
    const int nn = tl >> 2, k16 = (tl & 3) * 16;
#pragma unroll
    for (int h2 = 0; h2 < 2; h2++) {
      const float* Th = T + h2 * 4160;
      const int drow = map_row(n0_map + 64 * h2 + nn, mode, off);
      unsigned w0 = pack2(Th[(k16 + 0) * 65 + nn], Th[(k16 + 1) * 65 + nn]);
      unsigned w1 = pack2(Th[(k16 + 2) * 65 + nn], Th[(k16 + 3) * 65 + nn]);
      unsigned w2 = pack2(Th[(k16 + 4) * 65 + nn], Th[(k16 + 5) * 65 + nn]);
      unsigned w3 = pack2(Th[(k16 + 6) * 65 + nn], Th[(k16 + 7) * 65 + nn]);
      unsigned w4 = pack2(Th[(k16 + 8) * 65 + nn], Th[(k16 + 9) * 65 + nn]);
      unsigned w5 = pack2(Th[(k16 + 10) * 65 + nn], Th[(k16 + 11) * 65 + nn]);
      unsigned w6 = pack2(Th[(k16 + 12) * 65 + nn], Th[(k16 + 13) * 65 + nn]);
      unsigned w7 = pack2(Th[(k16 + 14) * 65 + nn], Th[(k16 + 15) * 65 + nn]);
      uint4* d = (uint4*)(dst + (size_t)drow * dst_ld + k0 + k16);
      d[0] = make_uint4(w0, w1, w2, w3);
      d[1] = make_uint4(w4, w5, w6, w7);
    }
  }
  __syncthreads();
}

__device__ __forceinline__ void ada_item(const Params& p, bool valid, int tl, int it, float* sm) {
  const int layer = it / 96, cb = it % 96;
  const int w = tl >> 6, lane = tl & 63;
  if (valid) {
    for (int i = tl; i < 3072; i += 256) {
      int cnd = i >> 10, k = i & 1023;
      float v = (cnd == 0) ? p.c_ctx[k] : p.c[(cnd - 1) * 1024 + k];
      sm[i] = v / (1.f + expf(-v));
    }
  }
  __syncthreads();
  float* red = sm + 3072;
  if (valid) {
    const float* wp = p.ada_w + (size_t)layer * 1024 * NMOD + (size_t)(w * 256) * NMOD + cb * 64 + lane;
    float a0 = 0.f, a1 = 0.f, a2 = 0.f;
    for (int k0 = 0; k0 < 256; k0 += 16) {
      float wv[16];
#pragma unroll
      for (int j = 0; j < 16; j++) wv[j] = __builtin_nontemporal_load(wp + (size_t)(k0 + j) * NMOD);
      __builtin_amdgcn_sched_barrier(0);
#pragma unroll
      for (int j = 0; j < 16; j++) {
        const int kk = w * 256 + k0 + j;
        a0 += sm[kk] * wv[j]; a1 += sm[1024 + kk] * wv[j]; a2 += sm[2048 + kk] * wv[j];
      }
    }
    red[(w * 3 + 0) * 64 + lane] = a0;
    red[(w * 3 + 1) * 64 + lane] = a1;
    red[(w * 3 + 2) * 64 + lane] = a2;
  }
  __syncthreads();
  if (valid && tl < 192) {
    int cnd = tl >> 6, l = tl & 63;
    float s = red[(0 * 3 + cnd) * 64 + l] + red[(1 * 3 + cnd) * 64 + l] + red[(2 * 3 + cnd) * 64 + l] + red[(3 * 3 + cnd) * 64 + l];
    int n = cb * 64 + l;
    float* mod = (float*)(p.ws + WS_MOD);
    mod[(size_t)(layer * 3 + cnd) * NMOD + n] = s + p.ada_b[layer * NMOD + n];
  }
  __syncthreads();
}

__device__ __forceinline__ void sincos_d(double x, double& s, double& c) {
  const double n = rint(x * 0.15915494309189533576888);
  double r = fma(-n, 6.283185307179586, x);
  r = fma(-n, 2.4492935982947064e-16, r);
  const double r2 = r * r;
  double ss = 1.0, cc = 1.0;
#pragma unroll
  for (int k = 14; k >= 1; k--) {
    ss = 1.0 - ss * r2 * (1.0 / (double)((2 * k) * (2 * k + 1)));
    cc = 1.0 - cc * r2 * (1.0 / (double)((2 * k - 1) * (2 * k)));
  }
  s = r * ss; c = cc;
}


__device__ void prep_items(const Params& p, unsigned char* smem, int stage, int vb, int nvb, int part) {
  const int t = tid_opaque();
  const int hb = t >> 8, tl = t & 255;
  float* T = (float*)(smem + hb * HALF_LDS);
  const int jl = stage >> 1;
  const bool na = !(stage & 1);
  const int S_ADA = (stage == 0 && gridDim.x != 256) ? 384 : 0;
  const int S_MIX = S_ADA + (na ? 384 + 128 : 256);
  const int S_W1 = S_MIX + 352, S_W3 = S_W1 + 352, S_W2 = S_W3 + 352;
  const int S_CKV = S_W2 + (stage == 0 ? 2048 : 0);
  const int S_END = S_CKV + (stage == 0 ? 64 : 0);
  const int plo = (part == 1) ? (S_MIX >> 1) : 0;
  const int phi = (part == 1) ? (S_W2 >> 1) : (S_END >> 1);
  for (int pi = plo + vb; pi < phi; pi += nvb) {
    if (part == 0 && pi * 2 >= S_MIX && pi * 2 < S_W2) continue;
    const int it = pi * 2 + hb;
    const bool valid = it < S_END;
    if (pi * 2 < S_ADA) {
      ada_item(p, valid, tl, it, T);
    } else if (pi * 2 < S_MIX) {
      int r = it - S_ADA;
      if (na) {
        if (r < 384) {
          int kt = r / 24, nt = r % 24;
          transpose_tile(valid, tl, p.w_qkv + (size_t)jl * 1024 * 3072, 3072, kt * 64, nt * 128,
                         (bf16_t*)(p.ws + WS_WQKV) + (size_t)jl * 3072 * 1024, 1024, nt * 128, 2, 0, T);
        } else {
          r -= 384; int kt = r / 8, nt = r % 8;
          transpose_tile(valid, tl, p.w_o + (size_t)jl * 1024 * 1024, 1024, kt * 64, nt * 128,
                         (bf16_t*)(p.ws + WS_WO) + (size_t)jl * 1024 * 1024, 1024, nt * 128, 0, 0, T);
        }
      } else {
        int kt = r / 16, nt = r % 16;
        int n0 = nt * 128;
        int gate = n0 >= 1024;
        transpose_tile(valid, tl, p.w_glu + (size_t)jl * 1024 * 2048, 2048, kt * 64, n0,
                       (bf16_t*)(p.ws + WS_WGLU) + (size_t)jl * 2048 * 1024, 1024, gate ? n0 - 1024 : n0, 1, gate ? 16 : 0, T);
      }
    } else if (pi * 2 < S_W1) {
      int r = it - S_MIX; int kt = r / 22, nt = r % 22;
      transpose_tile(valid, tl, p.w1 + (size_t)stage * 1024 * DFF, DFF, kt * 64, nt * 128,
                     (bf16_t*)(p.ws + WS_W13) + (size_t)stage * 5632 * 1024, 1024, nt * 128, 1, 0, T);
    } else if (pi * 2 < S_W3) {
      int r = it - S_W1; int kt = r / 22, nt = r % 22;
      transpose_tile(valid, tl, p.w3 + (size_t)stage * 1024 * DFF, DFF, kt * 64, nt * 128,
                     (bf16_t*)(p.ws + WS_W13) + (size_t)stage * 5632 * 1024, 1024, nt * 128, 1, 16, T);
    } else if (pi * 2 < S_W2) {
      int r = it - S_W3; int kt = r / 8, nt = r % 8;
      transpose_tile(valid, tl, p.w2 + (size_t)stage * DFF * 1024, 1024, kt * 64, nt * 128,
                     (bf16_t*)(p.ws + WS_W2) + (size_t)stage * 1024 * DFF, DFF, nt * 128, 0, 0, T);
    } else if (pi * 2 < S_CKV) {
      int r = it - S_W2; const int isv = r >= 1024; r &= 1023;
      int bjh = r >> 4, sc = r & 15; int bj = bjh >> 4, h = bjh & 15;
      int s = sc * 32 + (tl >> 3), d8 = (tl & 7) * 8;
      const float* src = (isv ? p.cache_v : p.cache_k) + ((size_t)(bj * 512 + s) * 16 + h) * 64 + d8;
      const f32x4 v0 = __builtin_nontemporal_load((const f32x4*)src), v1 = __builtin_nontemporal_load((const f32x4*)(src + 4));
      bf16_t* dst = (bf16_t*)(p.ws + (isv ? WS_CV : WS_CK)) + ((size_t)bjh * 512 + s) * 64 + d8;
      *(uint4*)dst = make_uint4(pack2(v0[0], v0[1]), pack2(v0[2], v0[3]), pack2(v1[0], v1[1]), pack2(v1[2], v1[3]));
    } else if (valid) {
      const int idx = (it - S_CKV) * 256 + tl;
      const double lr = (double)p.lam_re[idx], li = (double)p.lam_im[idx];
      const double step = exp((double)p.log_step[idx >> 6]);
      const double mag = exp(lr * step);
      double sn, cs;
      sincos_d(li * step, sn, cs);
      const double are = mag * cs, aim = mag * sn;
      const double den = lr * lr + li * li;
      const double nr = are - 1.0, ni = aim;
      float4 o;
      o.x = (float)are; o.y = (float)aim;
      o.z = (float)((nr * lr + ni * li) / den);
      o.w = (float)((ni * lr - nr * li) / den);
      ((float4*)(p.ws + WS_DISC))[idx] = o;
    }
  }
}

__device__ void ada_stage(const Params& p, unsigned char* smem, int layer, int vb, int nvb) {
  const int t = tid_opaque();
  const int w = t >> 6, lane = t & 63;
  float* sm = (float*)smem;
  float* red = sm + 3072;
  for (int cb = vb; cb < 96; cb += nvb) {
    for (int i = t; i < 3072; i += 512) {
      int cnd = i >> 10, k = i & 1023;
      float v = (cnd == 0) ? p.c_ctx[k] : p.c[(cnd - 1) * 1024 + k];
      sm[i] = v / (1.f + expf(-v));
    }
    __syncthreads();
    const float* wp = p.ada_w + (size_t)layer * 1024 * NMOD + (size_t)(w * 128) * NMOD + cb * 64 + lane;
    float a0 = 0.f, a1 = 0.f, a2 = 0.f;
    for (int k0 = 0; k0 < 128; k0 += 16) {
      float wv[16];
#pragma unroll
      for (int j = 0; j < 16; j++) wv[j] = __builtin_nontemporal_load(wp + (size_t)(k0 + j) * NMOD);
      __builtin_amdgcn_sched_barrier(0);
#pragma unroll
      for (int j = 0; j < 16; j++) {
        const int kk = w * 128 + k0 + j;
        a0 += sm[kk] * wv[j]; a1 += sm[1024 + kk] * wv[j]; a2 += sm[2048 + kk] * wv[j];
      }
    }
    red[(w * 3 + 0) * 64 + lane] = a0;
    red[(w * 3 + 1) * 64 + lane] = a1;
    red[(w * 3 + 2) * 64 + lane] = a2;
    __syncthreads();
    if (t < 192) {
      const int cnd = t >> 6, l = t & 63;
      float s = 0.f;
#pragma unroll
      for (int ww = 0; ww < 8; ww++) s += red[(ww * 3 + cnd) * 64 + l];
      const int n = cb * 64 + l;
      float* mod = (float*)(p.ws + WS_MOD);
      mod[(size_t)(layer * 3 + cnd) * NMOD + n] = s + p.ada_b[layer * NMOD + n];
    }
    __syncthreads();
  }
}

__device__ void norm_phase(const float* __restrict__ xctx, const float* __restrict__ xlat,
                           const float* __restrict__ g, const float* __restrict__ modl, int chunk,
                           bf16_t* __restrict__ h, float* __restrict__ hf, float* __restrict__ xcopy) {
  const int t_ = tid_opaque(); const int lane = t_ & 63, w = t_ >> 6;
  const int rstep = gridDim.x * 8;
  int row = blockIdx.x * 8 + w;
  f32x4 nv0, nv1, nv2, nv3;
  {
    const float* xr = (row < NCTX) ? xctx + (size_t)row * DM : xlat + (size_t)(row - NCTX) * DM;
    nv0 = *(const f32x4*)(xr + lane * 4); nv1 = *(const f32x4*)(xr + lane * 4 + 256);
    nv2 = *(const f32x4*)(xr + lane * 4 + 512); nv3 = *(const f32x4*)(xr + lane * 4 + 768);
  }
  for (; row < NTOK; row += rstep) {
    f32x4 v[4] = {nv0, nv1, nv2, nv3};
    const int rn = row + rstep;
    if (rn < NTOK) {
      const float* xr = (rn < NCTX) ? xctx + (size_t)rn * DM : xlat + (size_t)(rn - NCTX) * DM;
      nv0 = *(const f32x4*)(xr + lane * 4); nv1 = *(const f32x4*)(xr + lane * 4 + 256);
      nv2 = *(const f32x4*)(xr + lane * 4 + 512); nv3 = *(const f32x4*)(xr + lane * 4 + 768);
    }
    float ss = 0.f;
#pragma unroll
    for (int i = 0; i < 4; i++) ss += v[i][0] * v[i][0] + v[i][1] * v[i][1] + v[i][2] * v[i][2] + v[i][3] * v[i][3];
#pragma unroll
    for (int o = 32; o >= 1; o >>= 1) ss += __shfl_xor(ss, o);
    const float rstd = 1.0f / sqrtf(ss * (1.f / 1024.f) + 1e-6f);
    const int cond = (row < NCTX) ? 0 : 1 + ((row - NCTX) >> 10);
    const float* sh = modl + (size_t)cond * NMOD + chunk * 1024;
    const float* sc = sh + 1024;
#pragma unroll
    for (int i = 0; i < 4; i++) {
      int col = lane * 4 + 256 * i;
      float4 gg = *(const float4*)(g + col);
      float4 s1 = *(const float4*)(sc + col);
      float4 s0 = *(const float4*)(sh + col);
      float y0 = v[i][0] * rstd * gg.x * (1.f + s1.x) + s0.x;
      float y1 = v[i][1] * rstd * gg.y * (1.f + s1.y) + s0.y;
      float y2 = v[i][2] * rstd * gg.z * (1.f + s1.z) + s0.z;
      float y3 = v[i][3] * rstd * gg.w * (1.f + s1.w) + s0.w;
      if (h) *(uint2*)(h + (size_t)row * DM + col) = make_uint2(pack2(y0, y1), pack2(y2, y3));
      if (hf) *(float4*)(hf + (size_t)row * DM + col) = make_float4(y0, y1, y2, y3);
      if (xcopy) *(f32x4*)(xcopy + (size_t)row * DM + col) = v[i];
    }
  }
}

namespace pg8 {
constexpr int BM = 256, BK = 64, HALF = 128, HTB = HALF * BK * 2, NXCD = 8, WGM = 8;
__device__ __forceinline__ int lds_byte(int r, int c) { const int st = (r >> 4) * 2 + (c >> 5), rr = r & 15, cc = c & 31, ob = rr * 64 + cc * 2; return st * 1024 + (ob ^ (((ob >> 9) & 1) << 5)); }
__device__ __forceinline__ void stage_rc(int b, int& R, int& C) { const int st = b / 1024, sb = b % 1024, swz = sb ^ (((sb >> 9) & 1) << 5); R = (st >> 1) * 16 + swz / 64; C = (st & 1) * 32 + (swz % 64) / 2; }
struct Unit { int pm, pn; };
struct Gemm { const bf16_t* A; const bf16_t* Bt; int M, N, K; };
struct StaticOrder {
  int nM, nN, nwg, G, c;
  __device__ void init(int M, int N, int G_, int c_) { nM = M / BM; nN = N / BM; nwg = nM * nN; G = G_; c = c_; }
  __device__ bool next(int i, Unit& u) const {
    const long L = (long)i * G + c; if (L >= nwg) return false;
    int wgid = (int)L; { const int q = nwg / NXCD, r = nwg % NXCD, xcd = wgid % NXCD, off = wgid / NXCD; wgid = (xcd < r ? xcd * (q + 1) : r * (q + 1) + (xcd - r) * q) + off; }
    const int nig = WGM * nN, gid = wgid / nig, fm = gid * WGM, gsz = (nM - fm) < WGM ? (nM - fm) : WGM;
    u.pm = fm + ((wgid % nig) % gsz); u.pn = (wgid % nig) / gsz; return true;
  }
};

template <class Epi>
__device__ __forceinline__ void gemm_phase(LAS unsigned char* lds, const Gemm g, const StaticOrder& S, const Epi& E) {
  const int tid = tid_opaque(), wid = __builtin_amdgcn_readfirstlane(tid >> 6), lane = tid & 63, wr = wid >> 2, wc = wid & 3, fr = lane & 15, fq = lane >> 4;
  const int K = g.K, nt = K / BK;
  unsigned voffA[2], voffB[2];
#pragma unroll
  for (int i = 0; i < 2; ++i) { int R, C; stage_rc(tid * 16 + i * 8192, R, C);
    voffA[i] = (unsigned)(R * K + C) * 2u; voffB[i] = voffA[i]; }
  const size_t kstep = (size_t)(BK * 2);
  const size_t hstep = (size_t)HALF * K * 2;
  const size_t tstep = 2 * hstep;
  const unsigned ldsw = (unsigned)wid * 1024u;
  const int aoff = lds_byte(wr * 64 + fr, fq * 8), boff = lds_byte(wc * 32 + fr, fq * 8);
#define PG8_SA(b, h) (((b) * 2 + (h)) * HTB)
#define PG8_SB(b, h) ((4 + (b) * 2 + (h)) * HTB)
#define PG8_STAGE(bufoff, gbase, voff) do { _Pragma("unroll") for (int _i = 0; _i < 2; ++_i) \
    __builtin_amdgcn_global_load_lds((const unsigned*)((const char*)(gbase) + (voff)[_i]), (LAS unsigned*)(lds + (bufoff) + ldsw + _i * 8192), 16, 0, 0); } while (0)
#define PG8_LDA(dst, b, h) do { _Pragma("unroll") for (int m = 0; m < 4; ++m) _Pragma("unroll") for (int k = 0; k < 2; ++k) dst[m][k] = *(const LAS bf16x8*)(lds + PG8_SA(b, h) + aoff + m * 2048 + k * 1024); } while (0)
#define PG8_LDB(dst, b, h) do { _Pragma("unroll") for (int n = 0; n < 2; ++n) _Pragma("unroll") for (int k = 0; k < 2; ++k) dst[n][k] = *(const LAS bf16x8*)(lds + PG8_SB(b, h) + boff + n * 2048 + k * 1024); } while (0)
#define PG8_MMA(ai, bj, At, Bt) do { __builtin_amdgcn_s_setprio(1); _Pragma("unroll") for (int m = 0; m < 4; ++m) _Pragma("unroll") for (int n = 0; n < 2; ++n) _Pragma("unroll") for (int k = 0; k < 2; ++k) \
    acc[ai][bj][m][n] = __builtin_amdgcn_mfma_f32_16x16x32_bf16(Bt[n][k], At[m][k], acc[ai][bj][m][n], 0, 0, 0); __builtin_amdgcn_s_setprio(0); } while (0)
#define PG8_WAIT_V(n) asm volatile("s_waitcnt vmcnt(" #n ")" ::: "memory")
#define PG8_WAIT_L(n) asm volatile("s_waitcnt lgkmcnt(" #n ")" ::: "memory")
#define PG8_BAR __builtin_amdgcn_s_barrier()
#define PG8_SCHED __builtin_amdgcn_sched_barrier(0)
  Unit cur, nxt; int ui = 0;
  if (!S.next(0, cur)) return;
  f32x4 acc[2][2][4][2];
#pragma unroll
  for (int a = 0; a < 2; ++a)
#pragma unroll
    for (int b = 0; b < 2; ++b)
#pragma unroll
      for (int m = 0; m < 4; ++m)
#pragma unroll
        for (int n = 0; n < 2; ++n) acc[a][b][m][n] = (f32x4){0.f, 0.f, 0.f, 0.f};
  bf16x8 At[4][2], B0[2][2], B1[2][2];
  const char* cA = (const char*)g.A + (size_t)cur.pm * tstep; const char* cB = (const char*)g.Bt + (size_t)cur.pn * tstep;
  PG8_STAGE(PG8_SB(0, 0), cB, voffB); PG8_STAGE(PG8_SA(0, 0), cA, voffA); PG8_STAGE(PG8_SB(0, 1), cB + hstep, voffB); PG8_STAGE(PG8_SA(0, 1), cA + hstep, voffA);
  if (wr == 1) PG8_BAR;
  PG8_WAIT_V(4); PG8_BAR;
  PG8_STAGE(PG8_SB(1, 0), cB + kstep, voffB); PG8_STAGE(PG8_SA(1, 0), cA + kstep, voffA); PG8_STAGE(PG8_SB(1, 1), cB + hstep + kstep, voffB);
  PG8_WAIT_V(6); PG8_BAR;
  for (;;) {
    const bool has_next = S.next(ui + 1, nxt);
    const char* nA = has_next ? (const char*)g.A + (size_t)nxt.pm * tstep : cA; const char* nB = has_next ? (const char*)g.Bt + (size_t)nxt.pn * tstep : cB;
    for (int t = 0; t < nt; t += 2) {
      const bool last = (t == nt - 2);
      const char* a1 = cA + (size_t)(t + 1) * kstep;
      const char* a2 = last ? nA : cA + (size_t)(t + 2) * kstep; const char* b2 = last ? nB : cB + (size_t)(t + 2) * kstep;
      const char* a3 = a2 + kstep; const char* b3 = b2 + kstep;
      PG8_LDB(B0, 0, 0); PG8_SCHED; PG8_LDA(At, 0, 0); PG8_STAGE(PG8_SA(1, 1), a1 + hstep, voffA);
      PG8_WAIT_L(8); PG8_BAR; PG8_WAIT_L(0); PG8_MMA(0, 0, At, B0); PG8_BAR; PG8_SCHED;
      PG8_LDB(B1, 0, 1); PG8_STAGE(PG8_SB(0, 0), b2, voffB);
      PG8_BAR; PG8_WAIT_L(0); PG8_MMA(0, 1, At, B1); PG8_BAR;
      PG8_LDA(At, 0, 1); PG8_STAGE(PG8_SA(0, 0), a2, voffA);
      PG8_BAR; PG8_WAIT_L(0); PG8_MMA(1, 0, At, B0); PG8_BAR; PG8_SCHED;
      PG8_STAGE(PG8_SB(0, 1), b2 + hstep, voffB);
      PG8_WAIT_V(6); PG8_BAR; PG8_MMA(1, 1, At, B1); PG8_BAR;
      PG8_LDB(B0, 1, 0); PG8_SCHED; PG8_LDA(At, 1, 0); PG8_STAGE(PG8_SA(0, 1), a2 + hstep, voffA);
      PG8_WAIT_L(8); PG8_BAR; PG8_WAIT_L(0); PG8_MMA(0, 0, At, B0); PG8_BAR; PG8_SCHED;
      PG8_LDB(B1, 1, 1); PG8_STAGE(PG8_SB(1, 0), b3, voffB);
      PG8_BAR; PG8_WAIT_L(0); PG8_MMA(0, 1, At, B1); PG8_BAR;
      PG8_LDA(At, 1, 1); PG8_STAGE(PG8_SA(1, 0), a3, voffA);
      PG8_BAR; PG8_WAIT_L(0); PG8_MMA(1, 0, At, B0); PG8_BAR; PG8_SCHED;
      PG8_STAGE(PG8_SB(1, 1), b3 + hstep, voffB);
      PG8_WAIT_V(6); PG8_BAR; PG8_MMA(1, 1, At, B1); PG8_BAR;
    }
    E(acc, cur, wr, wc, fr, fq);
    if (!has_next) break;
#pragma unroll
    for (int a = 0; a < 2; ++a)
#pragma unroll
      for (int b = 0; b < 2; ++b)
#pragma unroll
        for (int m = 0; m < 4; ++m)
#pragma unroll
          for (int n = 0; n < 2; ++n) acc[a][b][m][n] = (f32x4){0.f, 0.f, 0.f, 0.f};
    cur = nxt; cA = nA; cB = nB; ++ui;
  }
  PG8_WAIT_V(0);
  if (wr == 0) PG8_BAR;
  PG8_BAR;
#undef PG8_SA
#undef PG8_SB
#undef PG8_STAGE
#undef PG8_LDA
#undef PG8_LDB
#undef PG8_MMA
#undef PG8_WAIT_V
#undef PG8_WAIT_L
#undef PG8_BAR
#undef PG8_SCHED
}
}

typedef f32x4 AccT[2][2][4][2];
__device__ __forceinline__ int cond_of_pm(int pm) { return (pm < 32) ? 0 : 1 + ((pm - 32) >> 2); }

struct EpiResid {
  float* x; const float* gate; const float* rctx; const float* rlat;
  __device__ __forceinline__ void operator()(const AccT& acc, const pg8::Unit& u, int wr, int wc, int fr, int fq) const {
    const int row0 = u.pm * 256 + wr * 64 + fr, col0 = u.pn * 256 + wc * 32 + 4 * fq;
    const float* g = gate + (size_t)cond_of_pm(u.pm) * NMOD;
    f32x4 gv[2][2];
#pragma unroll
    for (int bj = 0; bj < 2; ++bj)
#pragma unroll
      for (int n = 0; n < 2; ++n) gv[bj][n] = *(const f32x4*)(g + col0 + bj * 128 + n * 16);
    const float* rbase = (u.pm < 32) ? rctx : rlat - (size_t)NCTX * DM;
#pragma unroll
    for (int ai = 0; ai < 2; ++ai) {
      f32x4 xv[4][2][2];
#pragma unroll
      for (int m = 0; m < 4; ++m)
#pragma unroll
        for (int bj = 0; bj < 2; ++bj)
#pragma unroll
          for (int n = 0; n < 2; ++n)
            xv[m][bj][n] = *(const f32x4*)(rbase + (size_t)(row0 + ai * 128 + m * 16) * DM + col0 + bj * 128 + n * 16);
#pragma unroll
      for (int m = 0; m < 4; ++m)
#pragma unroll
        for (int bj = 0; bj < 2; ++bj)
#pragma unroll
          for (int n = 0; n < 2; ++n)
            *(f32x4*)(x + (size_t)(row0 + ai * 128 + m * 16) * DM + col0 + bj * 128 + n * 16) = xv[m][bj][n] + gv[bj][n] * acc[ai][bj][m][n];
    }
  }
};
struct EpiSwiglu {
  bf16_t* u;
  __device__ __forceinline__ void operator()(const AccT& acc, const pg8::Unit& un, int wr, int wc, int fr, int fq) const {
    const int row0 = un.pm * 256 + wr * 64 + fr;
#pragma unroll
    for (int ai = 0; ai < 2; ++ai)
#pragma unroll
      for (int m = 0; m < 4; ++m) {
        bf16_t* rowp = u + (size_t)(row0 + ai * 128 + m * 16) * DFF;
#pragma unroll
        for (int bj = 0; bj < 2; ++bj) {
          const int col = 16 * (un.pn * 8 + bj * 4 + wc) + 4 * fq;
          const f32x4 a1 = acc[ai][bj][m][0], a3 = acc[ai][bj][m][1];
          u32x2 w;
          w.x = pack2(silu_f(a1[0]) * a3[0], silu_f(a1[1]) * a3[1]);
          w.y = pack2(silu_f(a1[2]) * a3[2], silu_f(a1[3]) * a3[3]);
          *(u32x2*)(rowp + col) = w;
        }
      }
  }
};
struct EpiGlu {
  float* x; const float* gate;
  __device__ __forceinline__ void operator()(const AccT& acc, const pg8::Unit& un, int wr, int wc, int fr, int fq) const {
    const int row0 = un.pm * 256 + wr * 64 + fr;
    const float* g = gate + (size_t)cond_of_pm(un.pm) * NMOD;
    f32x4 gv[2], xv[2][2][4];
#pragma unroll
    for (int bj = 0; bj < 2; ++bj) {
      const int col = 16 * (un.pn * 8 + bj * 4 + wc) + 4 * fq;
      gv[bj] = *(const f32x4*)(g + col);
#pragma unroll
      for (int ai = 0; ai < 2; ++ai)
#pragma unroll
        for (int m = 0; m < 4; ++m) xv[bj][ai][m] = *(const f32x4*)(x + (size_t)(row0 + ai * 128 + m * 16) * DM + col);
    }
#pragma unroll
    for (int bj = 0; bj < 2; ++bj) {
      const int col = 16 * (un.pn * 8 + bj * 4 + wc) + 4 * fq;
#pragma unroll
      for (int ai = 0; ai < 2; ++ai)
#pragma unroll
        for (int m = 0; m < 4; ++m) {
          const f32x4 val = acc[ai][bj][m][0], gt = acc[ai][bj][m][1];
          f32x4 o;
#pragma unroll
          for (int e = 0; e < 4; ++e) o[e] = val[e] * __builtin_amdgcn_rcpf(1.f + __expf(-gt[e]));
          *(f32x4*)(x + (size_t)(row0 + ai * 128 + m * 16) * DM + col) = xv[bj][ai][m] + gv[bj] * o;
        }
    }
  }
};
struct EpiQKV {
  const float* qg; const float* kg; bf16_t* q; bf16_t* k; bf16_t* v; float* nk; float* nv;
  __device__ __forceinline__ void operator()(const AccT& acc, const pg8::Unit& u, int wr, int wc, int fr, int fq) const {
    const int which = u.pn >> 2, hh = ((u.pn & 3) << 2) + wc;
    const int row0 = u.pm * 256 + wr * 64 + fr;
    const int cc0 = hh * 64 + 4 * fq;
    if (which < 2) {
      const float* gain = (which == 0) ? qg : kg;
      bf16_t* dstb = (which == 0) ? q : k;
      const float qscale = (which == 0) ? 0.125f * 1.4426950408889634f : 1.0f;
      f32x4 gn[2][2];
#pragma unroll
      for (int bj = 0; bj < 2; ++bj)
#pragma unroll
        for (int n = 0; n < 2; ++n) gn[bj][n] = *(const f32x4*)(gain + 32 * bj + 16 * n + 4 * fq);
#pragma unroll
      for (int ai = 0; ai < 2; ++ai)
#pragma unroll
        for (int m = 0; m < 4; ++m) {
          float ss = 0.f;
#pragma unroll
          for (int bj = 0; bj < 2; ++bj)
#pragma unroll
            for (int n = 0; n < 2; ++n) {
              const f32x4 a = acc[ai][bj][m][n];
              ss += a[0] * a[0] + a[1] * a[1] + a[2] * a[2] + a[3] * a[3];
            }
          ss += __shfl_xor(ss, 16); ss += __shfl_xor(ss, 32);
          const float rinv = 1.0f / sqrtf(ss * (1.f / 64.f) + 1e-6f);
          const int row = row0 + ai * 128 + m * 16;
#pragma unroll
          for (int bj = 0; bj < 2; ++bj)
#pragma unroll
            for (int n = 0; n < 2; ++n) {
              const f32x4 val = acc[ai][bj][m][n] * rinv * gn[bj][n];
              const int cc = cc0 + 32 * bj + 16 * n;
              const f32x4 vs = val * qscale;
              u32x2 w; w.x = pack2(vs[0], vs[1]); w.y = pack2(vs[2], vs[3]);
              *(u32x2*)(dstb + (size_t)row * DM + cc) = w;
              if (which == 1 && row < NCTX) {
                const int b = row >> 8, s = row & 255;
                __builtin_nontemporal_store(val, (f32x4*)(nk + ((size_t)b * 512 + s) * DM + cc));
              }
            }
        }
    } else {
#pragma unroll
      for (int ai = 0; ai < 2; ++ai)
#pragma unroll
        for (int m = 0; m < 4; ++m) {
          const int row = row0 + ai * 128 + m * 16;
#pragma unroll
          for (int bj = 0; bj < 2; ++bj)
#pragma unroll
            for (int n = 0; n < 2; ++n) {
              const f32x4 val = acc[ai][bj][m][n];
              const int cc = cc0 + 32 * bj + 16 * n;
              u32x2 w; w.x = pack2(val[0], val[1]); w.y = pack2(val[2], val[3]);
              *(u32x2*)(v + (size_t)row * DM + cc) = w;
              if (row < NCTX) {
                const int b = row >> 8, s = row & 255;
                __builtin_nontemporal_store(val, (f32x4*)(nv + ((size_t)b * 512 + s) * DM + cc));
              }
            }
        }
    }
  }
};

template <class Epi>
__device__ __forceinline__ void run_gemm(unsigned char* smem, const bf16_t* A, const bf16_t* Bt, int N, int K, const Epi& E) {
  pg8::Gemm g; g.A = A; g.Bt = Bt; g.M = NTOK; g.N = N; g.K = K;
  pg8::StaticOrder S; S.init(NTOK, N, (int)gridDim.x, (int)blockIdx.x);
  pg8::gemm_phase<Epi>((LAS unsigned char*)smem, g, S, E);
}

template <int NPAIR, bool LOCAL>
__device__ __forceinline__ void attn_chunk(const bf16_t* Ks, const bf16_t* Vs, const float* rpbs,
                                           const bf16x8 (&qf)[2], float& m, float& lsum, f32x4 (&oacc)[4],
                                           int l15, int q, int key_col0, int keyrow0_minus_r, int qc, int col_start) {
  constexpr int NT = 2 * NPAIR;
  f32x4 s[NT];
  float mx = -1e30f;
#pragma unroll
  for (int T = 0; T < NT; T++) {
    const int tstart = LOCAL ? ((T >> 1) * 64 + key_col0 + 16 * (T & 1)) : T * 16;
    f32x4 a4 = zero4();
#pragma unroll
    for (int ks = 0; ks < 2; ks++) {
      bf16x8 a = *(const bf16x8*)(Ks + (tstart + l15) * 72 + ks * 32 + q * 8);
      a4 = __builtin_amdgcn_mfma_f32_16x16x32_bf16(a, qf[ks], a4, 0, 0, 0);
    }
#pragma unroll
    for (int j = 0; j < 4; j++) {
      float v = a4[j];
      if (LOCAL) {
        const int kc = key_col0 + 16 * (T & 1) + 4 * q + j;
        const int dr = keyrow0_minus_r + (T >> 1);
        int dc = kc - qc; dc = dc < -15 ? -15 : (dc > 15 ? 15 : dc);
        const bool inwin = (kc >= col_start) && (kc < col_start + 16);
        v = inwin ? v + rpbs[(dr + 7) * 31 + dc + 15] : -1e30f;
      }
      a4[j] = v;
      mx = fmaxf(mx, v);
    }
    s[T] = a4;
  }
  mx = fmaxf(mx, __shfl_xor(mx, 16));
  mx = fmaxf(mx, __shfl_xor(mx, 32));
  const float mnew = fmaxf(m, mx);
  const float alpha = __builtin_amdgcn_exp2f(m - mnew);
  m = mnew;
  lsum *= alpha;
#pragma unroll
  for (int dt = 0; dt < 4; dt++)
#pragma unroll
    for (int j = 0; j < 4; j++) oacc[dt][j] *= alpha;
#pragma unroll
  for (int T = 0; T < NT; T++)
#pragma unroll
    for (int j = 0; j < 4; j++) {
      float pv = __builtin_amdgcn_exp2f(s[T][j] - mnew);
      lsum += pv;
      s[T][j] = pv;
    }
#pragma unroll
  for (int pp = 0; pp < NPAIR; pp++) {
    const int T0 = 2 * pp, T1 = 2 * pp + 1;
    const int ts0 = LOCAL ? (pp * 64 + key_col0) : T0 * 16;
    const int ts1 = ts0 + 16;
    union { bf16x8 v; unsigned u[4]; } pb;
    pb.u[0] = pack2(s[T0][0], s[T0][1]); pb.u[1] = pack2(s[T0][2], s[T0][3]);
    pb.u[2] = pack2(s[T1][0], s[T1][1]); pb.u[3] = pack2(s[T1][2], s[T1][3]);
    const bf16_t* vb0 = Vs + (ts0 + 4 * q + (l15 >> 2)) * 72 + 4 * (l15 & 3);
    const bf16_t* vb1 = Vs + (ts1 + 4 * q + (l15 >> 2)) * 72 + 4 * (l15 & 3);
#pragma unroll
    for (int dt = 0; dt < 4; dt++) {
      const s16x4 v0 = __builtin_amdgcn_ds_read_tr16_b64_v4i16((LAS s16x4*)(vb0 + dt * 16));
      const s16x4 v1 = __builtin_amdgcn_ds_read_tr16_b64_v4i16((LAS s16x4*)(vb1 + dt * 16));
      bf16x8 av;
      av[0] = v0[0]; av[1] = v0[1]; av[2] = v0[2]; av[3] = v0[3];
      av[4] = v1[0]; av[5] = v1[1]; av[6] = v1[2]; av[7] = v1[3];
      oacc[dt] = __builtin_amdgcn_mfma_f32_16x16x32_bf16(av, pb.v, oacc[dt], 0, 0, 0);
    }
  }
}

__device__ __forceinline__ void attn_src(bool lat, int b, int h, int jl, int row_start, int c,
                                         const bf16_t* Kb, const bf16_t* Vb, const bf16_t* CK, const bf16_t* CV,
                                         const bf16_t*& Ksrc, const bf16_t*& Vsrc, int& kstride) {
  if (!lat) {
    const size_t o = (size_t)(b * 256 + c * 128) * DM + h * 64;
    Ksrc = Kb + o; Vsrc = Vb + o; kstride = DM;
  } else if (c < 4) {
    const int kr0 = row_start + 2 * c;
    const size_t o = (size_t)(NCTX + b * 1024 + kr0 * 64) * DM + h * 64;
    Ksrc = Kb + o; Vsrc = Vb + o; kstride = DM;
  } else {
    const int cc = c - 4;
    const size_t o = ((size_t)((b * 2 + jl) * 16 + h) * 512 + cc * 128) * 64;
    Ksrc = CK + o; Vsrc = CV + o; kstride = 64;
  }
}

__device__ void attn_phase(const Params& p, int jl, unsigned char* smem) {
  const int t = tid_opaque();
  const int hb = t >> 8, tl = t & 255;
  bf16_t* Ks = (bf16_t*)(smem + hb * HALF_LDS);
  bf16_t* Vs = Ks + 128 * 72;
  float* rpbs = (float*)(Vs + 128 * 72);
  const bf16_t* Qb = (const bf16_t*)(p.ws + WS_Q);
  const bf16_t* Kb = (const bf16_t*)(p.ws + WS_K);
  const bf16_t* Vb = (const bf16_t*)(p.ws + WS_V);
  const bf16_t* CK = (const bf16_t*)(p.ws + WS_CK);
  const bf16_t* CV = (const bf16_t*)(p.ws + WS_CV);
  bf16_t* Ob = (bf16_t*)(p.ws + WS_O);
  const int lane = tl & 63, w = tl >> 6, l15 = lane & 15, q = lane >> 4;
  const int lkey = tl >> 3, ld8 = (tl & 7) * 8;
  for (int pi = blockIdx.x; pi < 1280; pi += gridDim.x) {
    const int it = pi * 2 + hb;
    const bool lat = pi < 256;
    int b, h, r = 0, token, row_start = 0, key_col0 = 0, qc = 0, col_start = 0;
    if (lat) {
      b = it >> 8; h = (it >> 4) & 15; r = it & 15;
      token = NCTX + b * 1024 + r * 64 + w * 16 + l15;
      row_start = r - 4; row_start = row_start < 0 ? 0 : (row_start > 8 ? 8 : row_start);
      key_col0 = 16 * w - 8; key_col0 = key_col0 < 0 ? 0 : (key_col0 > 32 ? 32 : key_col0);
      qc = 16 * w + l15;
      col_start = qc - 8; col_start = col_start < 0 ? 0 : (col_start > 48 ? 48 : col_start);
    } else {
      const int i2 = it - 512;
      b = i2 >> 6; h = (i2 >> 2) & 15; const int qb = i2 & 3;
      token = b * 256 + qb * 64 + w * 16 + l15;
    }
    const int nch = lat ? 8 : 2;
    u32x4 rk0, rk1, rk2, rk3, rv0, rv1, rv2, rv3;
    {
      const bf16_t* Ksrc; const bf16_t* Vsrc; int kstride;
      attn_src(lat, b, h, jl, row_start, 0, Kb, Vb, CK, CV, Ksrc, Vsrc, kstride);
      const bf16_t* kp = Ksrc + (size_t)lkey * kstride + ld8; const bf16_t* vp = Vsrc + (size_t)lkey * kstride + ld8;
      rk0 = *(const u32x4*)(kp); rk1 = *(const u32x4*)(kp + (size_t)32 * kstride); rk2 = *(const u32x4*)(kp + (size_t)64 * kstride); rk3 = *(const u32x4*)(kp + (size_t)96 * kstride);
      rv0 = *(const u32x4*)(vp); rv1 = *(const u32x4*)(vp + (size_t)32 * kstride); rv2 = *(const u32x4*)(vp + (size_t)64 * kstride); rv3 = *(const u32x4*)(vp + (size_t)96 * kstride);
    }
    bf16x8 qf[2];
    qf[0] = *(const bf16x8*)(Qb + (size_t)token * DM + h * 64 + q * 8);
    qf[1] = *(const bf16x8*)(Qb + (size_t)token * DM + h * 64 + 32 + q * 8);
    float m = -1e30f, lsum = 0.f;
    f32x4 oacc[4];
#pragma unroll
    for (int dt = 0; dt < 4; dt++) oacc[dt] = zero4();
    for (int c = 0; c < nch; c++) {
      __syncthreads();
      *(u32x4*)(Ks + (lkey + 0) * 72 + ld8) = rk0; *(u32x4*)(Ks + (lkey + 32) * 72 + ld8) = rk1;
      *(u32x4*)(Ks + (lkey + 64) * 72 + ld8) = rk2; *(u32x4*)(Ks + (lkey + 96) * 72 + ld8) = rk3;
      *(u32x4*)(Vs + (lkey + 0) * 72 + ld8) = rv0; *(u32x4*)(Vs + (lkey + 32) * 72 + ld8) = rv1;
      *(u32x4*)(Vs + (lkey + 64) * 72 + ld8) = rv2; *(u32x4*)(Vs + (lkey + 96) * 72 + ld8) = rv3;
      if (lat && c == 0) {
        for (int i = tl; i < 465; i += 256) rpbs[i] = p.rpb[(size_t)(jl * 16 + h) * 465 + i] * 1.4426950408889634f;
      }
      __syncthreads();
      if (c + 1 < nch) {
        const bf16_t* Ksrc; const bf16_t* Vsrc; int kstride;
        attn_src(lat, b, h, jl, row_start, c + 1, Kb, Vb, CK, CV, Ksrc, Vsrc, kstride);
        const bf16_t* kp = Ksrc + (size_t)lkey * kstride + ld8; const bf16_t* vp = Vsrc + (size_t)lkey * kstride + ld8;
        rk0 = *(const u32x4*)(kp); rk1 = *(const u32x4*)(kp + (size_t)32 * kstride); rk2 = *(const u32x4*)(kp + (size_t)64 * kstride); rk3 = *(const u32x4*)(kp + (size_t)96 * kstride);
        rv0 = *(const u32x4*)(vp); rv1 = *(const u32x4*)(vp + (size_t)32 * kstride); rv2 = *(const u32x4*)(vp + (size_t)64 * kstride); rv3 = *(const u32x4*)(vp + (size_t)96 * kstride);
      }
      if (lat && c < 4) {
        attn_chunk<2, true>(Ks, Vs, rpbs, qf, m, lsum, oacc, l15, q, key_col0, row_start + 2 * c - r, qc, col_start);
      } else {
        attn_chunk<4, false>(Ks, Vs, rpbs, qf, m, lsum, oacc, l15, q, 0, 0, 0, 0);
      }
    }
    lsum += __shfl_xor(lsum, 16);
    lsum += __shfl_xor(lsum, 32);
    const float inv = 1.f / lsum;
#pragma unroll
    for (int dt = 0; dt < 4; dt++) {
      uint2 pk = make_uint2(pack2(oacc[dt][0] * inv, oacc[dt][1] * inv), pack2(oacc[dt][2] * inv, oacc[dt][3] * inv));
      *(uint2*)(Ob + (size_t)token * DM + h * 64 + dt * 16 + q * 4) = pk;
    }
  }
}

#define WAVE_SYNC() do { asm volatile("s_waitcnt lgkmcnt(0)" ::: "memory"); __builtin_amdgcn_wave_barrier(); asm volatile("" ::: "memory"); } while (0)
__device__ __forceinline__ float bf_lo(float x, unsigned hi_bits16) { return x - __uint_as_float(hi_bits16 << 16); }

__device__ void s5_phase(const Params& p, int jl, unsigned char* smem) {
  const int t = tid_opaque();
  const int lane = t & 63, w = t >> 6, l15 = lane & 15, q = lane >> 4;
  float* BuS = (float*)(smem + w * 17408);
  unsigned* XsH = (unsigned*)(BuS + 16 * 132);
  unsigned* XsL = XsH + 16 * 68;
  const float* HF = (const float*)(p.ws + WS_HF);
  bf16_t* YF = (bf16_t*)(p.ws + WS_YF);
  bf16_t* YB = (bf16_t*)(p.ws + WS_YB);
  const float4* DISC = (const float4*)(p.ws + WS_DISC);
  const bool latw = (w == 0);
  int it = latw ? (int)blockIdx.x : (w - 1) * (int)gridDim.x + (int)blockIdx.x;
  int itstep = latw ? (int)gridDim.x : (int)gridDim.x * 7;
  int itend = latw ? 256 : 4096;
  if (gridDim.x == 256 && !latw) {
    const int start = (w < 4) ? (w - 1) * 3 : (w == 4 ? 15 : 9 + (w - 5) * 2);
    const int cnt = (w < 4) ? 3 : (w == 4 ? 1 : 2);
    it = (int)blockIdx.x * 16 + start; itstep = 1; itend = it + cnt;
  }
  for (; it < itend; it += itstep) {
    const bool lat = latw;
    const int bt = lat ? 32 + (it >> 7) : (it >> 7);
    const int rest = it & 127;
    const int dir = rest >> 6, g = rest & 63;
    const int L = lat ? 1024 : 256;
    const int tokbase = lat ? NCTX + (bt - 32) * 1024 : bt * 256;
    const int pg = (jl * 2 + dir) * 64 + g;
    bf16x8 Bh[8];
    {
      const int c0 = 8 * (q & 1);
#pragma unroll
      for (int nn = 0; nn < 4; nn++) {
        const int ps = 16 * nn + l15;
        const float4 dd = DISC[pg * 64 + ps];
        const float fre = dd.z, fim = dd.w;
        const float4 br0 = *(const float4*)(p.b_re + (size_t)(pg * 64 + ps) * 16 + c0);
        const float4 br1 = *(const float4*)(p.b_re + (size_t)(pg * 64 + ps) * 16 + c0 + 4);
        const float4 bi0 = *(const float4*)(p.b_im + (size_t)(pg * 64 + ps) * 16 + c0);
        const float4 bi1 = *(const float4*)(p.b_im + (size_t)(pg * 64 + ps) * 16 + c0 + 4);
        float vr[8], vi[8];
        vr[0] = fre * br0.x - fim * bi0.x; vi[0] = fre * bi0.x + fim * br0.x;
        vr[1] = fre * br0.y - fim * bi0.y; vi[1] = fre * bi0.y + fim * br0.y;
        vr[2] = fre * br0.z - fim * bi0.z; vi[2] = fre * bi0.z + fim * br0.z;
        vr[3] = fre * br0.w - fim * bi0.w; vi[3] = fre * bi0.w + fim * br0.w;
        vr[4] = fre * br1.x - fim * bi1.x; vi[4] = fre * bi1.x + fim * br1.x;
        vr[5] = fre * br1.y - fim * bi1.y; vi[5] = fre * bi1.y + fim * br1.y;
        vr[6] = fre * br1.z - fim * bi1.z; vi[6] = fre * bi1.z + fim * br1.z;
        vr[7] = fre * br1.w - fim * bi1.w; vi[7] = fre * bi1.w + fim * br1.w;
        union { bf16x8 v; unsigned u[4]; } hr, hi;
#pragma unroll
        for (int e = 0; e < 4; e++) {
          hr.u[e] = pack2(vr[2 * e], vr[2 * e + 1]);
          hi.u[e] = pack2(vi[2 * e], vi[2 * e + 1]);
        }
        Bh[nn] = hr.v; Bh[4 + nn] = hi.v;
      }
    }
    bf16x8 Ch[4];
    {
      const float* cr = p.c_re + ((size_t)pg * 16 + l15) * 64 + 4 * q;
      const float* ci = p.c_im + ((size_t)pg * 16 + l15) * 64 + 4 * q;
#pragma unroll
      for (int kk = 0; kk < 4; kk++) {
        const float4 a = *(const float4*)(cr + 16 * kk);
        const float4 b = *(const float4*)(ci + 16 * kk);
        float v[8] = {a.x, -b.x, a.y, -b.y, a.z, -b.z, a.w, -b.w};
        union { bf16x8 v; unsigned u[4]; } h;
#pragma unroll
        for (int e = 0; e < 4; e++) h.u[e] = pack2(v[2 * e], v[2 * e + 1]);
        Ch[kk] = h.v;
      }
    }
    const float4 dme = DISC[pg * 64 + lane];
    const float a_re = dme.x, a_im = dme.y;
    float xr = 0.f, xi = 0.f;
    if (lat) {
      const size_t sidx = ((size_t)(((bt - 32) * 2 + jl) * 2 + dir) * 64 + g) * 64 + lane;
      xr = p.st_re[sidx]; xi = p.st_im[sidx];
    }
    const int nch = L >> 4;
    const float* ubase = HF + (size_t)(tokbase + l15) * DM + g * 16 + 8 * (q & 1);
    bf16_t* ybase = (dir ? YB : YF) + (size_t)(tokbase + l15) * DM + g * 16 + 4 * q;
    const float* usk = HF + (size_t)(tokbase + l15) * DM + g * 16 + 4 * q;
    float4 dsk4 = *(const float4*)(p.ssm_d + (size_t)jl * DM + g * 16 + 4 * q);
    if (dir) dsk4 = make_float4(0.f, 0.f, 0.f, 0.f);
    const int t00 = dir ? L - 16 : 0;
    const int tstep = dir ? -16 : 16;
    float4 ra0 = *(const float4*)(ubase + (size_t)t00 * DM),               ra1 = *(const float4*)(ubase + (size_t)t00 * DM + 4);
    float4 rb0 = *(const float4*)(ubase + (size_t)(t00 + tstep) * DM),     rb1 = *(const float4*)(ubase + (size_t)(t00 + tstep) * DM + 4);
    float4 rc0 = *(const float4*)(ubase + (size_t)(t00 + 2 * tstep) * DM), rc1 = *(const float4*)(ubase + (size_t)(t00 + 2 * tstep) * DM + 4);
    for (int ci = 0; ci < nch; ci++) {
      const int t0 = dir ? L - 16 * (ci + 1) : 16 * ci;
      const float4 u0 = ra0, u1 = ra1;
      const float4 usk4 = *(const float4*)(usk + (size_t)t0 * DM);
      ra0 = rb0; ra1 = rb1; rb0 = rc0; rb1 = rc1;
      if (ci + 3 < nch) {
        const int t0n = t0 + 3 * tstep;
        rc0 = *(const float4*)(ubase + (size_t)t0n * DM);
        rc1 = *(const float4*)(ubase + (size_t)t0n * DM + 4);
      }
      union { bf16x8 v; unsigned u[4]; } uh, ul;
      uh.u[0] = pack2(u0.x, u0.y); uh.u[1] = pack2(u0.z, u0.w); uh.u[2] = pack2(u1.x, u1.y); uh.u[3] = pack2(u1.z, u1.w);
      ul.u[0] = pack2(bf_lo(u0.x, uh.u[0] & 0xffffu), bf_lo(u0.y, uh.u[0] >> 16));
      ul.u[1] = pack2(bf_lo(u0.z, uh.u[1] & 0xffffu), bf_lo(u0.w, uh.u[1] >> 16));
      ul.u[2] = pack2(bf_lo(u1.x, uh.u[2] & 0xffffu), bf_lo(u1.y, uh.u[2] >> 16));
      ul.u[3] = pack2(bf_lo(u1.z, uh.u[3] & 0xffffu), bf_lo(u1.w, uh.u[3] >> 16));
      const bf16x8 uf = (q < 2) ? uh.v : ul.v;
      f32x4 d[8];
#pragma unroll
      for (int n = 0; n < 8; n++) d[n] = __builtin_amdgcn_mfma_f32_16x16x32_bf16(Bh[n], uf, zero4(), 0, 0, 0);
      WAVE_SYNC();
#pragma unroll
      for (int n = 0; n < 8; n++) *(f32x4*)(BuS + l15 * 132 + 16 * n + 4 * q) = d[n];
      WAVE_SYNC();
      float bur[16], bui[16];
#pragma unroll
      for (int s = 0; s < 16; s++) {
        const int rr = dir ? 15 - s : s;
        bur[s] = BuS[rr * 132 + lane];
        bui[s] = BuS[rr * 132 + 64 + lane];
      }
      __builtin_amdgcn_sched_barrier(0);
#pragma unroll
      for (int s = 0; s < 16; s++) {
        const int rr = dir ? 15 - s : s;
        const float nxr = a_re * xr - a_im * xi + bur[s];
        const float nxi = a_re * xi + a_im * xr + bui[s];
        xr = nxr; xi = nxi;
        XsH[rr * 68 + lane] = pack2(xr, xi);
      }
      WAVE_SYNC();
      f32x4 acc0 = zero4(), acc1 = zero4();
#pragma unroll
      for (int kk = 0; kk < 4; kk++) {
        const bf16x8 xh = *(const bf16x8*)(XsH + l15 * 68 + 16 * kk + 4 * q);
        if (kk & 1) acc1 = __builtin_amdgcn_mfma_f32_16x16x32_bf16(Ch[kk], xh, acc1, 0, 0, 0);
        else        acc0 = __builtin_amdgcn_mfma_f32_16x16x32_bf16(Ch[kk], xh, acc0, 0, 0, 0);
      }
      const f32x4 acc2 = zero4();
      {
        const f32x4 yv = acc0 + (acc1 + acc2);
        u32x2 yw;
        yw.x = pack2(yv[0] + dsk4.x * usk4.x, yv[1] + dsk4.y * usk4.y);
        yw.y = pack2(yv[2] + dsk4.z * usk4.z, yv[3] + dsk4.w * usk4.w);
        *(u32x2*)(ybase + (size_t)t0 * DM) = yw;
      }
    }
    if (!lat) {
      const size_t oidx = ((size_t)((bt * 2 + jl) * 2 + dir) * 64 + g) * 64 + lane;
      p.out[OUT_SRE + oidx] = xr;
      p.out[OUT_SIM + oidx] = xi;
    }
  }
}

__device__ void combine_phase(const Params& p, int jl) {
  const u32x2* YF = (const u32x2*)(p.ws + WS_YF);
  const u32x2* YB = (const u32x2*)(p.ws + WS_YB);
  u32x2* Z = (u32x2*)(p.ws + WS_H);
  const size_t n4 = (size_t)NTOK * DM / 4;
  const int t_ = tid_opaque();
  for (size_t i = (size_t)blockIdx.x * 512 + t_; i < n4; i += (size_t)gridDim.x * 512) {
    const u32x2 a = __builtin_nontemporal_load(YF + i), b = __builtin_nontemporal_load(YB + i);
    const float y0 = __uint_as_float(a.x << 16) + __uint_as_float(b.x << 16);
    const float y1 = __uint_as_float(a.x & 0xffff0000u) + __uint_as_float(b.x & 0xffff0000u);
    const float y2 = __uint_as_float(a.y << 16) + __uint_as_float(b.y << 16);
    const float y3 = __uint_as_float(a.y & 0xffff0000u) + __uint_as_float(b.y & 0xffff0000u);
    u32x2 z; z.x = pack2(gelu_tanh(y0), gelu_tanh(y1)); z.y = pack2(gelu_tanh(y2), gelu_tanh(y3));
    Z[i] = z;
  }
}

#define XB_TMO      128
#define XB_XCNT(j)  (256  + 64 * (j))
#define XB_XSUB(j)  (1280 + 64 * (j))
#define XB_XGEN(j)  (2304 + 64 * (j))
#define XB_TOP      3328
#define XB_TOPGEN   3392
#define XCD_BAR_WORDS 3456
#define XB_SPIN_CAP (1u << 22)

__device__ __forceinline__ unsigned xb_ld(unsigned* p)              { return __hip_atomic_load(p, __ATOMIC_RELAXED, __HIP_MEMORY_SCOPE_AGENT); }
__device__ __forceinline__ unsigned xb_add(unsigned* p, unsigned v) { return __hip_atomic_fetch_add(p, v, __ATOMIC_RELAXED, __HIP_MEMORY_SCOPE_AGENT); }
__device__ __forceinline__ unsigned xb_xcc_id() { return (unsigned)__builtin_amdgcn_s_getreg((3 << 11) | 20) & 0xFu; }
#define XB_SPIN(cond, bar) do { unsigned _sp = 0; while (cond) { __builtin_amdgcn_s_sleep(1); \
    if ((++_sp & 255u) == 0u) { if (xb_ld(&(bar)[XB_TMO])) break; if (_sp > XB_SPIN_CAP) { atomicAdd(&(bar)[XB_TMO], 1u); break; } } } } while (0)

struct XcdBarrier { unsigned* bar; unsigned x; volatile LAS unsigned* st; };

__device__ __forceinline__ XcdBarrier xcd_barrier_post(unsigned* bar, volatile LAS unsigned* st) {
  XcdBarrier b; b.bar = bar; b.x = xb_xcc_id(); b.st = st;
  if (threadIdx.x == 0) (void)xb_add(&bar[XB_XCNT(b.x)], 1u);
  return b;
}
__device__ __forceinline__ void xcd_barrier_complete(unsigned* bar, unsigned x, unsigned& nloc, unsigned& nx) {
  const unsigned G = gridDim.x * gridDim.y * gridDim.z;
  unsigned sum, cnt, mine, sp = 0u;
  for (;;) {
    sum = 0u; cnt = 0u; mine = 0u;
#pragma unroll
    for (unsigned j = 0; j < 16; ++j) { const unsigned c = xb_ld(&bar[XB_XCNT(j)]); sum += c; cnt += (c > 0u) ? 1u : 0u; mine = (j == x) ? c : mine; }
    if (sum == G) break;
    __builtin_amdgcn_s_sleep(1);
    if ((++sp & 255u) == 0u) { if (xb_ld(&bar[XB_TMO])) break; if (sp > XB_SPIN_CAP) { atomicAdd(&bar[XB_TMO], 1u); break; } }
  }
  nloc = mine > 0u ? mine : 1u; nx = cnt > 0u ? cnt : 1u;
}
__device__ __forceinline__ void xcd_barrier(unsigned* bar_, volatile LAS unsigned* st_) {
  XcdBarrier b; b.bar = bar_; b.x = xb_xcc_id(); b.st = st_;
  asm volatile("s_waitcnt vmcnt(0)" ::: "memory");
  __syncthreads();
  if (threadIdx.x == 0) {
    unsigned* bar = b.bar;
    __builtin_amdgcn_s_waitcnt(0);
    unsigned nloc = b.st[0], nx = b.st[1];
    if (nloc == 0u) { xcd_barrier_complete(bar, b.x, nloc, nx); b.st[0] = nloc; b.st[1] = nx; }
    const unsigned old = xb_add(&bar[XB_XSUB(b.x)], 1u);
    const unsigned gen = old / nloc;
    if (old + 1u == (gen + 1u) * nloc) {
      __builtin_amdgcn_fence(__ATOMIC_RELEASE, "agent");
      asm volatile("s_waitcnt vmcnt(0)" ::: "memory");
      const unsigned og = xb_add(&bar[XB_TOP], 1u);
      const unsigned tg = og / nx;
      if (og + 1u == (tg + 1u) * nx) xb_add(&bar[XB_TOPGEN], 1u);
      else XB_SPIN(xb_ld(&bar[XB_TOPGEN]) == tg, bar);
      __builtin_amdgcn_fence(__ATOMIC_ACQUIRE, "agent");
      xb_add(&bar[XB_XGEN(b.x)], 1u);
      asm volatile("s_waitcnt vmcnt(0)" ::: "memory");
    } else {
      XB_SPIN(xb_ld(&bar[XB_XGEN(b.x)]) == gen, bar);
      __builtin_amdgcn_fence(__ATOMIC_ACQUIRE, "agent");
      asm volatile("s_waitcnt vmcnt(0)" ::: "memory");
    }
  }
  __syncthreads();
}

__global__ void __launch_bounds__(512, 2) mega_kernel(Params p) {
  extern __shared__ __attribute__((aligned(16))) unsigned char smem[];
  cg::grid_group grid = cg::this_grid();
  if (threadIdx.x == 0) *(uint4*)(smem + SMEM_BAR) = make_uint4(0u, 0u, 0u, 0u);
  __syncthreads();
  (void)xcd_barrier_post((unsigned*)(p.ws + WS_BAR), (volatile LAS unsigned*)(smem + SMEM_BAR));
#define GSYNC() xcd_barrier((unsigned*)(p.ws + WS_BAR), (volatile LAS unsigned*)(smem + SMEM_BAR))
  if (p.ws == nullptr) grid.sync();
  const float* mod = (const float*)(p.ws + WS_MOD);
  bf16_t* H = (bf16_t*)(p.ws + WS_H);
  float* X = p.out + OUT_X;

  if ((int)gridDim.x == 256) {
    if ((int)blockIdx.x < 96) ada_stage(p, smem, 0, (int)blockIdx.x, 96);
    else prep_items(p, smem, 0, (int)blockIdx.x - 96, 160, 0);
  } else {
    prep_items(p, smem, 0, (int)blockIdx.x, (int)gridDim.x, 2);
  }
  GSYNC();

#pragma unroll 1
  for (int i = 0; i < 4; i++) {
    const int jl = i >> 1;
    const bool ssm = (i & 1);
    const float* modl = mod + (size_t)i * 3 * NMOD;
    if (i == 0)
      norm_phase(p.x_prompt, p.x_sample, p.norm_mix + i * DM, modl, 0, H, nullptr, nullptr);
    else
      norm_phase(X, X + (size_t)NCTX * DM, p.norm_mix + i * DM, modl, 0, ssm ? nullptr : H, ssm ? (float*)(p.ws + WS_HF) : nullptr, nullptr);
    GSYNC();
    if (!ssm) {
      EpiQKV eq;
      eq.qg = p.q_gain + jl * 64; eq.kg = p.k_gain + jl * 64;
      eq.q = (bf16_t*)(p.ws + WS_Q); eq.k = (bf16_t*)(p.ws + WS_K); eq.v = (bf16_t*)(p.ws + WS_V);
      eq.nk = p.out + OUT_NK + (size_t)jl * 256 * DM; eq.nv = p.out + OUT_NV + (size_t)jl * 256 * DM;
      run_gemm(smem, H, (const bf16_t*)(p.ws + WS_WQKV) + (size_t)jl * 3072 * 1024, 3072, 1024, eq);
      GSYNC();
      attn_phase(p, jl, smem);
      GSYNC();
      EpiResid er; er.x = X; er.gate = modl + 2 * 1024;
      er.rctx = (i == 0) ? p.x_prompt : X; er.rlat = (i == 0) ? p.x_sample : X + (size_t)NCTX * DM;
      run_gemm(smem, (const bf16_t*)(p.ws + WS_O), (const bf16_t*)(p.ws + WS_WO) + (size_t)jl * 1024 * 1024, 1024, 1024, er);
      if (i == 0 && (int)blockIdx.x >= 160 && (int)gridDim.x == 256)
        prep_items(p, smem, 0, (int)blockIdx.x - 160, (int)gridDim.x - 160, 1);
      GSYNC();
    } else {
      s5_phase(p, jl, smem);
      GSYNC();
      combine_phase(p, jl);
      GSYNC();
      EpiGlu eg; eg.x = X; eg.gate = modl + 2 * 1024;
      run_gemm(smem, H, (const bf16_t*)(p.ws + WS_WGLU) + (size_t)jl * 2048 * 1024, 2048, 1024, eg);
      GSYNC();
    }
    norm_phase(X, X + (size_t)NCTX * DM, p.norm_ffn + i * DM, modl, 3, H, nullptr, nullptr);
    GSYNC();
    EpiSwiglu es; es.u = (bf16_t*)(p.ws + WS_U);
    run_gemm(smem, H, (const bf16_t*)(p.ws + WS_W13) + (size_t)i * 5632 * 1024, 5632, 1024, es);
    if (i < 3 && (int)gridDim.x == 256 && (int)blockIdx.x >= 112)
      ada_stage(p, smem, i + 1, (int)blockIdx.x - 112, 144);
    GSYNC();
    EpiResid ed; ed.x = X; ed.gate = modl + 5 * 1024; ed.rctx = X; ed.rlat = X + (size_t)NCTX * DM;
    run_gemm(smem, (const bf16_t*)(p.ws + WS_U), (const bf16_t*)(p.ws + WS_W2) + (size_t)i * 1024 * DFF, 1024, DFF, ed);
    if (i < 3 && (int)blockIdx.x >= 160 && (int)gridDim.x > 160)
      prep_items(p, smem, i + 1, (int)blockIdx.x - 160, (int)gridDim.x - 160, 2);
    GSYNC();
  }
}

extern "C" void kernel_launch(void* const* d_in, const int* in_sizes, int n_in, void* d_out, int out_size,
                              void* d_ws, size_t ws_size, hipStream_t stream) {
  static int grid_blocks = 0;
  if (!grid_blocks) {
    int dev = 0, cus = 0, per_cu = 0;
    (void)hipGetDevice(&dev);
    (void)hipDeviceGetAttribute(&cus, hipDeviceAttributeMultiprocessorCount, dev);
    (void)hipFuncSetAttribute((const void*)mega_kernel, hipFuncAttributeMaxDynamicSharedMemorySize, SMEM_BYTES);
    (void)hipOccupancyMaxActiveBlocksPerMultiprocessor(&per_cu, mega_kernel, 512, SMEM_BYTES);
    if (per_cu > 1) per_cu = 1;
    if (per_cu < 1) per_cu = 1;
    grid_blocks = cus * per_cu;
  }
  if (ws_size < WS_END) { fprintf(stderr, "workspace too small: %zu < %zu\n", ws_size, (size_t)WS_END); return; }
  Params p{};
  const float** pp = (const float**)&p;
  for (int i = 0; i < 29; i++) pp[i] = (const float*)d_in[i];
  p.out = (float*)d_out;
  p.ws = (unsigned char*)d_ws;
  (void)hipMemsetAsync((unsigned char*)d_ws + WS_BAR, 0, XCD_BAR_WORDS * 4, stream);
  void* args[] = {&p};
  hipError_t err = hipLaunchCooperativeKernel((void*)mega_kernel, dim3(grid_blocks), dim3(512), args, SMEM_BYTES, stream);
  if (err != hipSuccess) fprintf(stderr, "cooperative launch failed: %s (grid %d)\n", hipGetErrorString(err), grid_blocks);
}
```
